# Optimizing an MI355X kernel written in HIP

```python
import math
import jax, jax.numpy as jnp
from jax import lax
import numpy as np

D_MODEL = 1024
BATCH = 8
SEQ = 4096
DEPTH = 1

D_MIX = D_MODEL
ATT_HEADS = 8
ATT_HEAD_DIM = 64
ATT_WIDTH = ATT_HEADS * ATT_HEAD_DIM
DILATED_GROUPS = ((128, 1), (512, 4), (2048, 16))
ATT_BLOCK = 128
MLSTM_HEADS = 4
MLSTM_HEAD_DIM = 128
MLSTM_WIDTH = MLSTM_HEADS * MLSTM_HEAD_DIM
MLSTM_CHUNK = 64
MLSTM_CONV = 4
D_FF = 2816
FFN_CONV = 3
EPS = 1e-6
PROJ_WIDTH = 3 * ATT_WIDTH + 4 * MLSTM_WIDTH + 2 * MLSTM_HEADS
SPLITS = (ATT_WIDTH, 2 * ATT_WIDTH, 3 * ATT_WIDTH,
          3 * ATT_WIDTH + MLSTM_WIDTH, 3 * ATT_WIDTH + 2 * MLSTM_WIDTH,
          3 * ATT_WIDTH + 3 * MLSTM_WIDTH, 3 * ATT_WIDTH + 4 * MLSTM_WIDTH,
          3 * ATT_WIDTH + 4 * MLSTM_WIDTH + MLSTM_HEADS)

kernel_name = "hymba_dilated_mlstm_convffn"


def _rmsnorm(x, w):
    xf = x.astype(jnp.float32)
    y = xf * lax.rsqrt(jnp.mean(xf * xf, axis=-1, keepdims=True) + EPS)
    return (y * w.astype(jnp.float32)).astype(x.dtype)


def _causal_dwconv(x, w, b):
    K = w.shape[0]
    S = x.shape[1]
    xp = jnp.pad(x, ((0, 0), (K - 1, 0), (0, 0)))
    y = b
    for j in range(K):
        y = y + xp[:, j:j + S, :] * w[j]
    return y


def _banded_attention(q, k, v, span):
    N, L, H, Dh = q.shape
    nb = -(-L // ATT_BLOCK)
    Lp = nb * ATT_BLOCK
    pad = ((0, 0), (0, Lp - L), (0, 0), (0, 0))

    def blocks(t):
        return jnp.pad(t.astype(jnp.float32), pad).reshape(N, nb, ATT_BLOCK, H, Dh)

    qb, kb, vb = blocks(q), blocks(k), blocks(v)

    def with_prev(t):
        prev = jnp.pad(t, ((0, 0), (1, 0), (0, 0), (0, 0), (0, 0)))[:, :-1]
        return jnp.concatenate([prev, t], axis=2)

    kk, vv = with_prev(kb), with_prev(vb)
    s = jnp.einsum('nbqhd,nbkhd->nbhqk', qb, kk) * (Dh ** -0.5)
    qi = jnp.arange(ATT_BLOCK)[:, None]
    kj = jnp.arange(2 * ATT_BLOCK)[None, :]
    dist = ATT_BLOCK + qi - kj
    key_pos = (jnp.arange(nb)[:, None, None] - 1) * ATT_BLOCK + kj[None]
    mask = (dist >= 0) & (dist <= span) & (key_pos >= 0)
    s = jnp.where(mask[None, :, None], s, -jnp.inf)
    m = jnp.max(s, axis=-1, keepdims=True)
    p = jnp.exp(s - m)
    den = jnp.sum(p, axis=-1, keepdims=True)
    o = jnp.einsum('nbhqk,nbkhd->nbqhd', p / den, vv).reshape(N, Lp, H, Dh)[:, :L]
    lse = (m + jnp.log(den))[..., 0].transpose(0, 1, 3, 2).reshape(N, Lp, H)[:, :L]
    return o, lse


def _dilated_attention(q, k, v):
    B, S, H, Dh = q.shape
    outs, lses = [], []
    for window, dil in DILATED_GROUPS:
        L = S // dil

        def to_sub(t):
            return t.reshape(B, L, dil, H, Dh).transpose(0, 2, 1, 3, 4).reshape(B * dil, L, H, Dh)

        o, lse = _banded_attention(to_sub(q), to_sub(k), to_sub(v), window // dil)
        outs.append(o.reshape(B, dil, L, H, Dh).transpose(0, 2, 1, 3, 4).reshape(B, S, H, Dh))
        lses.append(lse.reshape(B, dil, L, H).transpose(0, 2, 1, 3).reshape(B, S, H))
    wts = jax.nn.softmax(jnp.stack(lses, axis=0), axis=0)
    return jnp.sum(wts[..., None] * jnp.stack(outs, axis=0), axis=0)


def _mlstm_chunkwise(q, k, v, log_i, log_f):
    B, S, H, D = q.shape
    Lc = MLSTM_CHUNK
    nc = S // Lc

    def chunks(t):
        return t.reshape(B, nc, Lc, H, D).transpose(0, 3, 1, 2, 4)

    def chunks_g(t):
        return t.reshape(B, nc, Lc, H).transpose(0, 3, 1, 2)

    qc, kc, vc = chunks(q), chunks(k), chunks(v)
    li, lf = chunks_g(log_i), chunks_g(log_f)
    bcum = jnp.cumsum(lf, axis=-1)
    g = bcum[..., -1]
    a = g[..., None] - bcum + li

    def step(carry, xs):
        C, n, m = carry
        k_j, v_j, a_j, g_j = xs
        m_new = jnp.maximum(g_j + m, jnp.max(a_j, axis=-1))
        decay = jnp.exp(g_j + m - m_new)
        w = jnp.exp(a_j - m_new[..., None])
        C_new = decay[..., None, None] * C + jnp.einsum('bhs,bhsv,bhsk->bhvk', w, v_j, k_j)
        n_new = decay[..., None] * n + jnp.einsum('bhs,bhsk->bhk', w, k_j)
        return (C_new, n_new, m_new), (C, n, m)

    init = (jnp.zeros((B, H, D, D), jnp.float32), jnp.zeros((B, H, D), jnp.float32),
            jnp.zeros((B, H), jnp.float32))
    xs = (kc.transpose(2, 0, 1, 3, 4), vc.transpose(2, 0, 1, 3, 4),
          a.transpose(2, 0, 1, 3), g.transpose(2, 0, 1))
    _, (C_prev, n_prev, m_prev) = lax.scan(step, init, xs)
    C_prev = C_prev.transpose(1, 2, 0, 3, 4)
    n_prev = n_prev.transpose(1, 2, 0, 3)
    m_prev = m_prev.transpose(1, 2, 0)

    causal = jnp.tril(jnp.ones((Lc, Lc), dtype=bool))
    dmat = jnp.where(causal, bcum[..., :, None] - bcum[..., None, :] + li[..., None, :], -jnp.inf)
    inter_log = bcum + m_prev[..., None]
    m_t = jnp.maximum(inter_log, jnp.max(dmat, axis=-1))
    scores = jnp.einsum('bhctd,bhcsd->bhcts', qc, kc) * jnp.exp(dmat - m_t[..., None])
    inter = jnp.exp(inter_log - m_t)
    num = (jnp.einsum('bhcts,bhcsd->bhctd', scores, vc)
           + inter[..., None] * jnp.einsum('bhcvk,bhctk->bhctv', C_prev, qc))
    den = jnp.sum(scores, axis=-1) + inter * jnp.einsum('bhck,bhctk->bhct', n_prev, qc)
    h = num / jnp.maximum(jnp.abs(den), jnp.exp(-m_t))[..., None]
    return h.transpose(0, 2, 3, 1, 4).reshape(B, S, H, D)


def _hybrid_mixer(h, w_in, mlstm_conv_w, mlstm_conv_b, mlstm_i_bias, mlstm_f_bias,
                  att_out_norm_w, mlstm_out_norm_w, w_out):
    B, S, _ = h.shape
    proj = h @ w_in
    aq, ak, av, mq, mk, mv, mo, mig, mfg = jnp.split(proj, SPLITS, axis=-1)

    def att_heads(t):
        return t.reshape(B, S, ATT_HEADS, ATT_HEAD_DIM)

    att = _dilated_attention(att_heads(aq), att_heads(ak), att_heads(av))
    att = _rmsnorm(att, att_out_norm_w.reshape(ATT_HEADS, ATT_HEAD_DIM)).reshape(B, S, ATT_WIDTH)

    mqk = jax.nn.silu(_causal_dwconv(jnp.concatenate([mq, mk], axis=-1), mlstm_conv_w, mlstm_conv_b))
    mq, mk = jnp.split(mqk, 2, axis=-1)

    def ml_heads(t):
        return t.astype(jnp.float32).reshape(B, S, MLSTM_HEADS, MLSTM_HEAD_DIM)

    log_i = (mig + mlstm_i_bias).astype(jnp.float32)
    log_f = jax.nn.log_sigmoid((mfg + mlstm_f_bias).astype(jnp.float32))
    hm = _mlstm_chunkwise(ml_heads(mq), ml_heads(mk) * (MLSTM_HEAD_DIM ** -0.5), ml_heads(mv),
                          log_i, log_f)
    hm = _rmsnorm(hm, mlstm_out_norm_w.reshape(MLSTM_HEADS, MLSTM_HEAD_DIM)).reshape(B, S, MLSTM_WIDTH)
    hm = jax.nn.sigmoid(mo.astype(jnp.float32)) * hm

    y = jnp.concatenate([att, hm], axis=-1).astype(h.dtype)
    return y @ w_out


def _conv_ffn(h, w_ffn_up, ffn_conv_w, ffn_conv_b, w_ffn_down):
    u = _causal_dwconv(h @ w_ffn_up, ffn_conv_w, ffn_conv_b)
    gate, val = jnp.split(u, 2, axis=-1)
    return (jax.nn.silu(gate) * val) @ w_ffn_down


def setup_inputs(seed: int = 0) -> dict:
    key = jax.random.key(seed)
    ks = jax.random.split(key, 17)
    f32 = jnp.float32

    def nrm(k, shape, scale):
        return jax.random.normal(k, shape, f32) * scale

    def gain(k, shape):
        return 1.0 + 0.02 * jax.random.normal(k, shape, f32)

    f_bias = (jnp.linspace(3.0, 6.0, MLSTM_HEADS, dtype=f32)[None, :]
              + 0.1 * jax.random.normal(ks[5], (DEPTH, MLSTM_HEADS), f32))
    return {
        "x": jax.random.normal(ks[0], (BATCH, SEQ, D_MODEL), f32),
        "w_in": nrm(ks[1], (DEPTH, D_MODEL, PROJ_WIDTH), D_MODEL ** -0.5),
        "mlstm_conv_w": nrm(ks[2], (DEPTH, MLSTM_CONV, 2 * MLSTM_WIDTH), MLSTM_CONV ** -0.5),
        "mlstm_conv_b": nrm(ks[3], (DEPTH, 2 * MLSTM_WIDTH), 0.01),
        "mlstm_i_bias": nrm(ks[4], (DEPTH, MLSTM_HEADS), 0.1),
        "mlstm_f_bias": f_bias,
        "att_out_norm_w": gain(ks[6], (DEPTH, ATT_WIDTH)),
        "mlstm_out_norm_w": gain(ks[7], (DEPTH, MLSTM_WIDTH)),
        "w_out": nrm(ks[8], (DEPTH, D_MIX, D_MODEL), D_MIX ** -0.5),
        "mixer_norm_w": gain(ks[9], (DEPTH, D_MODEL)),
        "ffn_norm_w": gain(ks[10], (DEPTH, D_MODEL)),
        "w_ffn_up": nrm(ks[11], (DEPTH, D_MODEL, 2 * D_FF), D_MODEL ** -0.5),
        "ffn_conv_w": nrm(ks[12], (DEPTH, FFN_CONV, 2 * D_FF), FFN_CONV ** -0.5),
        "ffn_conv_b": nrm(ks[13], (DEPTH, 2 * D_FF), 0.01),
        "w_ffn_down": nrm(ks[14], (DEPTH, D_FF, D_MODEL), D_FF ** -0.5),
        "final_norm_w": gain(ks[15], (D_MODEL,)),
    }


def reference(x, w_in, mlstm_conv_w, mlstm_conv_b, mlstm_i_bias, mlstm_f_bias,
              att_out_norm_w, mlstm_out_norm_w, w_out, mixer_norm_w, ffn_norm_w,
              w_ffn_up, ffn_conv_w, ffn_conv_b, w_ffn_down, final_norm_w):
    h = x
    for layer in range(DEPTH):
        h = h + _hybrid_mixer(_rmsnorm(h, mixer_norm_w[layer]), w_in[layer],
                              mlstm_conv_w[layer], mlstm_conv_b[layer],
                              mlstm_i_bias[layer], mlstm_f_bias[layer],
                              att_out_norm_w[layer], mlstm_out_norm_w[layer], w_out[layer])
        h = h + _conv_ffn(_rmsnorm(h, ffn_norm_w[layer]), w_ffn_up[layer],
                          ffn_conv_w[layer], ffn_conv_b[layer], w_ffn_down[layer])
    return _rmsnorm(h, final_norm_w)
```

```cpp
#define H_BF16 1
#define NOHACK2 1
#include <hip/hip_runtime.h>
#include <hip/hip_cooperative_groups.h>
#include <cstdio>
#include <cstdint>
namespace cg = cooperative_groups;
namespace pg8 {
#define PG8_LAS __attribute__((address_space(3)))
typedef unsigned short bf16_t;
typedef short bf16x8 __attribute__((ext_vector_type(8)));
typedef float f32x4 __attribute__((ext_vector_type(4)));
typedef unsigned u32x4 __attribute__((ext_vector_type(4)));
constexpr int BM = 256, BK = 64, HALF = 128, HTB = HALF * BK * 2  , STAGE_BYTES = 8 * HTB, NXCD = 8, WGM = 8;

__host__ __device__ __forceinline__ int lds_byte(int r, int c) { const int st = (r >> 4) * 2 + (c >> 5), rr = r & 15, cc = c & 31, ob = rr * 64 + cc * 2; return st * 1024 + (ob ^ (((ob >> 9) & 1) << 5)); }
__host__ __device__ __forceinline__ void stage_rc(int b, int& R, int& C) { const int st = b / 1024, sb = b % 1024, swz = sb ^ (((sb >> 9) & 1) << 5); R = (st >> 1) * 16 + swz / 64; C = (st & 1) * 32 + (swz % 64) / 2; }
__host__ __device__ __forceinline__ int perm32(int rho) { const int n = rho >> 4, i = rho & 15; return 8 * (i >> 2) + 4 * n + (i & 3); }

struct Unit { int pm, pn; };
struct Gemm { const bf16_t* A; const bf16_t* Bt; int M, N, K, lda; };

struct StaticOrder {
    int nM, nN, nwg, G, c;
    __host__ __device__ void init(int M, int N, int G_, int c_) { nM = M / BM; nN = N / BM; nwg = nM * nN; G = G_; c = c_; }
    __host__ __device__ bool next(int i, Unit& u) const {
        const long L = (long)i * G + c; if (L >= nwg) return false;
        int wgid = (int)L; { const int q = nwg / NXCD, r = nwg % NXCD, xcd = wgid % NXCD, off = wgid / NXCD; wgid = (xcd < r ? xcd * (q + 1) : r * (q + 1) + (xcd - r) * q) + off; }
        const int nig = WGM * nN, gid = wgid / nig, fm = gid * WGM, gsz = (nM - fm) < WGM ? (nM - fm) : WGM;
        u.pm = fm + ((wgid % nig) % gsz); u.pn = (wgid % nig) / gsz; return true;
    }
    __device__ __forceinline__ void a_ready(const Unit&) const {}
    __device__ __forceinline__ void done(const Unit&) const {}
};

__device__ __forceinline__ unsigned cvt_pk_bf16(float lo, float hi) { unsigned r; asm volatile("v_cvt_pk_bf16_f32 %0, %1, %2" : "=v"(r) : "v"(lo), "v"(hi)); return r; }
typedef float f32x2 __attribute__((ext_vector_type(2)));
__device__ __forceinline__ f32x2 gelu_pk(f32x2 v) {
    const f32x2 av = __builtin_elementwise_abs(v), d = av * 0.2316418882f + 1.0f;
    f32x2 t; t.x = __builtin_amdgcn_rcpf(d.x); t.y = __builtin_amdgcn_rcpf(d.y);
    f32x2 q = t * 0.5307027145f + (-0.7265760135f); q = q * t + 0.7107068705f; q = q * t + (-0.142248368f); q = q * t + 0.127414796f; q = q * t;
    const f32x2 s = (v * v) * (-0.72134752044f);
    f32x2 e; e.x = __builtin_amdgcn_exp2f(s.x); e.y = __builtin_amdgcn_exp2f(s.y);
    const f32x2 m = v * (q * e), r = v - m;
    f32x2 o; o.x = v.x < 0.f ? m.x : r.x; o.y = v.y < 0.f ? m.y : r.y; return o;
}

template <int ACT  > struct EpiBf16 {
    static constexpr bool PERM = true, AFTER_DRAIN = false; static_assert(ACT == 0 || ACT == 1, "EpiBf16: ACT is 0 (none) or 1 (gelu_pk)");
    bf16_t* O; int ldc; const float* bias; int split_cols; size_t split_stride; float scale0;
    __device__ __forceinline__ void operator()(const f32x4 (&acc)[2][2][4][2], const Unit& u, int wr, int wc, int fr, int fq) const {
        const int row0 = u.pm * BM + wr * 64 + fr; int colt = u.pn * BM; bf16_t* base = O;
        float sc = 1.f; if (split_cols) { const int t = colt / split_cols; base += (size_t)t * split_stride; colt -= t * split_cols; if (t == 0) sc = scale0; }
        const int col0 = colt + wc * 32 + 8 * fq, bcol0 = u.pn * BM + wc * 32 + 8 * fq;
        f32x4 bv[2][2];
#pragma unroll
        for (int bj = 0; bj < 2; ++bj)
#pragma unroll
            for (int n = 0; n < 2; ++n) bv[bj][n] = bias ? *(const f32x4*)(bias + bcol0 + bj * HALF + 4 * n) : (f32x4){0.f, 0.f, 0.f, 0.f};
#pragma unroll
        for (int ai = 0; ai < 2; ++ai)
#pragma unroll
            for (int m = 0; m < 4; ++m) { bf16_t* rowp = base + (size_t)(row0 + ai * HALF + m * 16) * ldc + col0;
#pragma unroll
                for (int bj = 0; bj < 2; ++bj) { f32x4 v0 = acc[ai][bj][m][0] + bv[bj][0], v1 = acc[ai][bj][m][1] + bv[bj][1];
                    if (ACT == 1) { f32x2 a = gelu_pk((f32x2){v0[0], v0[1]}), b = gelu_pk((f32x2){v0[2], v0[3]}), c = gelu_pk((f32x2){v1[0], v1[1]}), d = gelu_pk((f32x2){v1[2], v1[3]});
                        v0 = (f32x4){a.x, a.y, b.x, b.y}; v1 = (f32x4){c.x, c.y, d.x, d.y}; }
                    v0 = v0 * sc; v1 = v1 * sc; u32x4 w; w.x = cvt_pk_bf16(v0[0], v0[1]); w.y = cvt_pk_bf16(v0[2], v0[3]); w.z = cvt_pk_bf16(v1[0], v1[1]); w.w = cvt_pk_bf16(v1[2], v1[3]);
                    *(u32x4*)(rowp + bj * HALF) = w; } }
    }
};

template <class Epi, class Sched, bool ALIGN_EPI = false, bool SP2 = false>
__device__ __forceinline__ void gemm_phase(PG8_LAS unsigned char* lds, const Gemm g, const Sched& S, const Epi& E) {
    int tid_ = threadIdx.x; asm volatile("" : "+v"(tid_)); const int tid = tid_, wid = __builtin_amdgcn_readfirstlane(tid >> 6), lane = tid & 63, wr = wid >> 2, wc = wid & 3, fr = lane & 15, fq = lane >> 4;
    const int K = g.K, nt = K / BK;
    unsigned voffA[2], voffB[2];
#pragma unroll
    for (int i = 0; i < 2; ++i) { int R, C; stage_rc(tid * 16 + i * 8192, R, C); const int Rb = Epi::PERM ? ((R & ~31) + perm32(R & 31)) : R;
        voffA[i] = (unsigned)(R * g.lda + C) * 2u; voffB[i] = (unsigned)(Rb * K + C) * 2u; }
    const size_t kstep = (size_t)(BK * 2);
    const size_t hstep = (size_t)HALF * K * 2;
    const size_t tstep = 2 * hstep;
    const size_t hstepA = (size_t)HALF * g.lda * 2, tstepA = 2 * hstepA;
    const unsigned ldsw = (unsigned)wid * 1024u;
    const int aoff = lds_byte(wr * 64 + fr, fq * 8), boff = lds_byte(wc * 32 + fr, fq * 8);
#define PG8_SA(b, h) (((b) * 2 + (h)) * HTB)
#define PG8_SB(b, h) ((4 + (b) * 2 + (h)) * HTB)
#define PG8_STAGE(bufoff, gbase, voff) do { _Pragma("unroll") for (int _i = 0; _i < 2; ++_i) \
        __builtin_amdgcn_global_load_lds((const unsigned*)((const char*)(gbase) + (voff)[_i]), (PG8_LAS unsigned*)(lds + (bufoff) + ldsw + _i * 8192), 16, 0, 0); } while (0)
#define PG8_LDA(dst, b, h) do { _Pragma("unroll") for (int m = 0; m < 4; ++m) _Pragma("unroll") for (int k = 0; k < 2; ++k) dst[m][k] = *(const PG8_LAS bf16x8*)(lds + PG8_SA(b, h) + aoff + m * 2048 + k * 1024); } while (0)
#define PG8_LDB(dst, b, h) do { _Pragma("unroll") for (int n = 0; n < 2; ++n) _Pragma("unroll") for (int k = 0; k < 2; ++k) dst[n][k] = *(const PG8_LAS bf16x8*)(lds + PG8_SB(b, h) + boff + n * 2048 + k * 1024); } while (0)
#define PG8_MMA(ai, bj, At, Bt) do { __builtin_amdgcn_s_setprio(1); _Pragma("unroll") for (int m = 0; m < 4; ++m) _Pragma("unroll") for (int n = 0; n < 2; ++n) _Pragma("unroll") for (int k = 0; k < 2; ++k) \
        acc[ai][bj][m][n] = __builtin_amdgcn_mfma_f32_16x16x32_bf16(Bt[n][k], At[m][k], acc[ai][bj][m][n], 0, 0, 0); __builtin_amdgcn_s_setprio(0); } while (0)
#define PG8_WAIT_V(n) asm volatile("s_waitcnt vmcnt(" #n ")" ::: "memory")
#define PG8_WAIT_L(n) asm volatile("s_waitcnt lgkmcnt(" #n ")" ::: "memory")
#define PG8_BAR __builtin_amdgcn_s_barrier()
#define PG8_SCHED __builtin_amdgcn_sched_barrier(0)
    Unit cur, nxt; int ui = 0;
    if (!S.next(0, cur)) return;
    f32x4 acc[2][2][4][2];
#pragma unroll
    for (int a = 0; a < 2; ++a)
#pragma unroll
        for (int b = 0; b < 2; ++b)
#pragma unroll
            for (int m = 0; m < 4; ++m)
#pragma unroll
                for (int n = 0; n < 2; ++n) acc[a][b][m][n] = (f32x4){0.f, 0.f, 0.f, 0.f};
    bf16x8 At[4][2], B0[2][2], B1[2][2];
    const char* cA = (const char*)g.A + (size_t)cur.pm * tstepA; const char* cB = (const char*)g.Bt + (size_t)cur.pn * tstep;
    S.a_ready(cur);
    if constexpr (SP2) {
        PG8_STAGE(PG8_SB(0, 0), cB, voffB); PG8_STAGE(PG8_SB(0, 1), cB + hstep, voffB); PG8_STAGE(PG8_SA(0, 0), cA, voffA); PG8_STAGE(PG8_SA(0, 1), cA + hstepA, voffA);
        if (wr == 1) PG8_BAR;
        PG8_WAIT_V(2); PG8_BAR;
        PG8_STAGE(PG8_SB(1, 0), cB + kstep, voffB); PG8_STAGE(PG8_SA(1, 0), cA + kstep, voffA); PG8_STAGE(PG8_SB(1, 1), cB + hstep + kstep, voffB);
        PG8_WAIT_V(6); PG8_BAR;
    } else {
        PG8_STAGE(PG8_SB(0, 0), cB, voffB); PG8_STAGE(PG8_SA(0, 0), cA, voffA); PG8_STAGE(PG8_SB(0, 1), cB + hstep, voffB); PG8_STAGE(PG8_SA(0, 1), cA + hstepA, voffA);
        if (wr == 1) PG8_BAR;
        PG8_WAIT_V(4); PG8_BAR;
        PG8_STAGE(PG8_SB(1, 0), cB + kstep, voffB); PG8_STAGE(PG8_SA(1, 0), cA + kstep, voffA); PG8_STAGE(PG8_SB(1, 1), cB + hstep + kstep, voffB);
        PG8_WAIT_V(6); PG8_BAR;
    }
    for (;;) {
        const bool has_next = S.next(ui + 1, nxt);
        const char* nA = has_next ? (const char*)g.A + (size_t)nxt.pm * tstepA : cA; const char* nB = has_next ? (const char*)g.Bt + (size_t)nxt.pn * tstep : cB;
        for (int t = 0; t < nt; t += 2) {
            const bool last = (t == nt - 2);
            const char* a1 = cA + (size_t)(t + 1) * kstep;
            const char* a2 = last ? nA : cA + (size_t)(t + 2) * kstep; const char* b2 = last ? nB : cB + (size_t)(t + 2) * kstep;
            const char* a3 = a2 + kstep; const char* b3 = b2 + kstep;
            if (last && has_next) S.a_ready(nxt);
            if constexpr (SP2) {
            PG8_LDB(B0, 0, 0); PG8_LDB(B1, 0, 1); PG8_SCHED; PG8_LDA(At, 0, 0); PG8_STAGE(PG8_SA(1, 1), a1 + hstepA, voffA);
            PG8_WAIT_V(8); PG8_WAIT_L(0); PG8_BAR; PG8_MMA(0, 0, At, B0); PG8_MMA(0, 1, At, B1); PG8_BAR; PG8_SCHED;
            PG8_LDA(At, 0, 1); PG8_STAGE(PG8_SB(0, 0), b2, voffB); PG8_STAGE(PG8_SB(0, 1), b2 + hstep, voffB); PG8_STAGE(PG8_SA(0, 0), a2, voffA);
            PG8_WAIT_V(8); PG8_WAIT_L(0); PG8_BAR; PG8_MMA(1, 0, At, B0); PG8_MMA(1, 1, At, B1); PG8_BAR; PG8_SCHED;
            PG8_LDB(B0, 1, 0); PG8_LDB(B1, 1, 1); PG8_SCHED; PG8_LDA(At, 1, 0); PG8_STAGE(PG8_SA(0, 1), a2 + hstepA, voffA);
            PG8_WAIT_V(8); PG8_WAIT_L(0); PG8_BAR; PG8_MMA(0, 0, At, B0); PG8_MMA(0, 1, At, B1); PG8_BAR; PG8_SCHED;
            PG8_LDA(At, 1, 1); PG8_STAGE(PG8_SB(1, 0), b3, voffB); PG8_STAGE(PG8_SB(1, 1), b3 + hstep, voffB); PG8_STAGE(PG8_SA(1, 0), a3, voffA);
            PG8_WAIT_V(8); PG8_WAIT_L(0); PG8_BAR; PG8_MMA(1, 0, At, B0); PG8_MMA(1, 1, At, B1); PG8_BAR; PG8_SCHED;
            } else {
            PG8_LDB(B0, 0, 0); PG8_SCHED; PG8_LDA(At, 0, 0); PG8_STAGE(PG8_SA(1, 1), a1 + hstepA, voffA);
            PG8_WAIT_L(8); PG8_BAR; PG8_WAIT_L(0); PG8_MMA(0, 0, At, B0); PG8_BAR; PG8_SCHED;
            PG8_LDB(B1, 0, 1); PG8_STAGE(PG8_SB(0, 0), b2, voffB);
            PG8_BAR; PG8_WAIT_L(0); PG8_MMA(0, 1, At, B1); PG8_BAR;
            PG8_LDA(At, 0, 1); PG8_STAGE(PG8_SA(0, 0), a2, voffA);
            PG8_BAR; PG8_WAIT_L(0); PG8_MMA(1, 0, At, B0); PG8_BAR; PG8_SCHED;
            PG8_STAGE(PG8_SB(0, 1), b2 + hstep, voffB);
            PG8_WAIT_V(6); PG8_BAR; PG8_MMA(1, 1, At, B1); PG8_BAR;
            PG8_LDB(B0, 1, 0); PG8_SCHED; PG8_LDA(At, 1, 0); PG8_STAGE(PG8_SA(0, 1), a2 + hstepA, voffA);
            PG8_WAIT_L(8); PG8_BAR; PG8_WAIT_L(0); PG8_MMA(0, 0, At, B0); PG8_BAR; PG8_SCHED;
            PG8_LDB(B1, 1, 1); PG8_STAGE(PG8_SB(1, 0), b3, voffB);
            PG8_BAR; PG8_WAIT_L(0); PG8_MMA(0, 1, At, B1); PG8_BAR;
            PG8_LDA(At, 1, 1); PG8_STAGE(PG8_SA(1, 0), a3, voffA);
            PG8_BAR; PG8_WAIT_L(0); PG8_MMA(1, 0, At, B0); PG8_BAR; PG8_SCHED;
            PG8_STAGE(PG8_SB(1, 1), b3 + hstep, voffB);
            PG8_WAIT_V(6); PG8_BAR; PG8_MMA(1, 1, At, B1); PG8_BAR;
            }
        }
        if constexpr (ALIGN_EPI) { if (wr == 0) PG8_BAR; }
        if constexpr (!Epi::AFTER_DRAIN) { E(acc, cur, wr, wc, fr, fq); S.done(cur); }
        if (!has_next) break;
#pragma unroll
        for (int a = 0; a < 2; ++a)
#pragma unroll
            for (int b = 0; b < 2; ++b)
#pragma unroll
                for (int m = 0; m < 4; ++m)
#pragma unroll
                    for (int n = 0; n < 2; ++n) acc[a][b][m][n] = (f32x4){0.f, 0.f, 0.f, 0.f};
        cur = nxt; cA = nA; cB = nB; ++ui;
        if constexpr (ALIGN_EPI) { if (wr == 1) PG8_BAR; }
    }
    PG8_WAIT_V(0);
    if constexpr (!ALIGN_EPI) { if (wr == 0) PG8_BAR; }
    PG8_BAR;
    if constexpr (Epi::AFTER_DRAIN) { E.fused(acc, cur, wr, wc, fr, fq, lds, wid, lane); S.done(cur); }
#undef PG8_SA
#undef PG8_SB
#undef PG8_STAGE
#undef PG8_LDA
#undef PG8_LDB
#undef PG8_MMA
#undef PG8_WAIT_V
#undef PG8_WAIT_L
#undef PG8_BAR
#undef PG8_SCHED
}
}

namespace pg8 {
typedef unsigned u32x2 __attribute__((ext_vector_type(2)));
__device__ __forceinline__ float dpp_shr1(float old, float src) { return __builtin_bit_cast(float, __builtin_amdgcn_update_dpp(__builtin_bit_cast(int, old), __builtin_bit_cast(int, src), 0x111, 0xf, 0xf, false)); }
__device__ __forceinline__ float dpp_shr2(float old, float src) { return __builtin_bit_cast(float, __builtin_amdgcn_update_dpp(__builtin_bit_cast(int, old), __builtin_bit_cast(int, src), 0x112, 0xf, 0xf, false)); }
__device__ __forceinline__ float dpp_shl15(float src) { return __builtin_bit_cast(float, __builtin_amdgcn_update_dpp(0, __builtin_bit_cast(int, src), 0x10F, 0xf, 0xf, true)); }
__device__ __forceinline__ float dpp_shl14(float src) { return __builtin_bit_cast(float, __builtin_amdgcn_update_dpp(0, __builtin_bit_cast(int, src), 0x10E, 0xf, 0xf, true)); }
__device__ __forceinline__ float silu_f(float v) { return v * __builtin_amdgcn_rcpf(1.0f + __expf(-v)); }

struct EpiOut {
    static constexpr bool PERM = false, AFTER_DRAIN = false;
    const float* x; float* out; bf16_t* hb; float* rowss;
    __device__ __forceinline__ void operator()(const f32x4 (&acc)[2][2][4][2], const Unit& u, int wr, int wc, int fr, int fq) const {
        const int col0 = u.pn * BM + wc * 32 + 4 * fq;
#pragma unroll
        for (int ai = 0; ai < 2; ++ai)
#pragma unroll
            for (int m = 0; m < 4; ++m) {
                const int row = u.pm * BM + ai * HALF + wr * 64 + m * 16 + fr; const size_t off = (size_t)row * 1024 + col0; float ss = 0.f;
#pragma unroll
                for (int bj = 0; bj < 2; ++bj)
#pragma unroll
                    for (int n = 0; n < 2; ++n) { const size_t o = off + bj * HALF + n * 16; const f32x4 xv = *(const f32x4*)(x + o); const f32x4 h = acc[ai][bj][m][n] + xv;
#ifndef H_BF16
                        *(f32x4*)(out + o) = h;
#endif
                        ss += (h[0] * h[0] + h[1] * h[1]) + (h[2] * h[2] + h[3] * h[3]);
                        u32x2 w; w.x = cvt_pk_bf16(h[0], h[1]); w.y = cvt_pk_bf16(h[2], h[3]); *(u32x2*)(hb + o) = w; }
                ss += __shfl_xor(ss, 16); ss += __shfl_xor(ss, 32);
                if (fq == 0) atomicAdd(rowss + row, ss);
            }
    }
};
struct EpiDown {
    static constexpr bool PERM = false, AFTER_DRAIN = false;
    float* out; float* rowss2; bf16_t* hb;
    __device__ __forceinline__ void operator()(const f32x4 (&acc)[2][2][4][2], const Unit& u, int wr, int wc, int fr, int fq) const {
        const int col0 = u.pn * BM + wc * 32 + 4 * fq;
#pragma unroll
        for (int ai = 0; ai < 2; ++ai)
#pragma unroll
            for (int m = 0; m < 4; ++m) {
                const int row = u.pm * BM + ai * HALF + wr * 64 + m * 16 + fr; const size_t off = (size_t)row * 1024 + col0; float ss = 0.f;
#pragma unroll
                for (int bj = 0; bj < 2; ++bj)
#pragma unroll
                    for (int n = 0; n < 2; ++n) { const size_t o = off + bj * HALF + n * 16;
#ifdef H_BF16
                        const u32x2 xb = *(const u32x2*)(hb + o); const f32x4 xv = {__uint_as_float(xb.x << 16), __uint_as_float(xb.x & 0xffff0000u), __uint_as_float(xb.y << 16), __uint_as_float(xb.y & 0xffff0000u)};
#else
                        const f32x4 xv = *(const f32x4*)(out + o);
#endif
#ifdef DBG_ZERO_FFN
                        const f32x4 h = xv;
#else
                        const f32x4 h = acc[ai][bj][m][n] + xv;
#endif

#ifdef H_BF16
                        { u32x2 w; w.x = cvt_pk_bf16(h[0], h[1]); w.y = cvt_pk_bf16(h[2], h[3]); *(u32x2*)(hb + o) = w; }
#else
                        *(f32x4*)(out + o) = h;
#endif
                        ss += (h[0] * h[0] + h[1] * h[1]) + (h[2] * h[2] + h[3] * h[3]); }
                ss += __shfl_xor(ss, 16); ss += __shfl_xor(ss, 32);
                if (fq == 0) atomicAdd(rowss2 + row, ss);
            }
    }
};
struct EpiUp {
    static constexpr bool PERM = true, AFTER_DRAIN = false;
    bf16_t* G; float* EDGE; const float* rowss; const float* cw; const float* cb; PG8_LAS float* halo;
    __device__ __forceinline__ void operator()(f32x4 (&acc)[2][2][4][2], const Unit& u, int wr, int wc, int fr, int fq) const {
#pragma unroll
        for (int ai = 0; ai < 2; ++ai)
#pragma unroll
            for (int m = 0; m < 4; ++m) { const int row = u.pm * BM + ai * HALF + wr * 64 + m * 16 + fr; float rs = rsqrtf(rowss[row] * (1.0f / 1024.0f) + 1e-6f);
#ifdef DBG_RS1
                rs = 1.0f;
#endif
#pragma unroll
                for (int bj = 0; bj < 2; ++bj)
#pragma unroll
                    for (int n = 0; n < 2; ++n) acc[ai][bj][m][n] = acc[ai][bj][m][n] * rs; }
        const int tc0 = wc * 32 + 8 * fq;
        if (fr >= 14) {
#pragma unroll
            for (int ai = 0; ai < 2; ++ai)
#pragma unroll
                for (int bj = 0; bj < 2; ++bj)
#pragma unroll
                    for (int n = 0; n < 2; ++n) *(PG8_LAS f32x4*)(halo + ((ai * 2 + wr) * 2 + (fr - 14)) * 256 + bj * HALF + tc0 + 4 * n) = acc[ai][bj][3][n];
#ifndef DBG_NOHALO
            if (wr == 1) {
#pragma unroll
                for (int bj = 0; bj < 2; ++bj)
#pragma unroll
                    for (int n = 0; n < 2; ++n) *(f32x4*)(EDGE + ((size_t)u.pm * 4 + 2 + (fr - 14)) * 5632 + u.pn * BM + bj * HALF + tc0 + 4 * n) = acc[1][bj][3][n];
            }
#endif
        }
#ifndef DBG_NOHALO
        if (fr < 2 && wr == 0) {
#pragma unroll
            for (int bj = 0; bj < 2; ++bj)
#pragma unroll
                for (int n = 0; n < 2; ++n) *(f32x4*)(EDGE + ((size_t)u.pm * 4 + fr) * 5632 + u.pn * BM + bj * HALF + tc0 + 4 * n) = acc[0][bj][0][n];
        }
#endif
        asm volatile("s_waitcnt lgkmcnt(0)" ::: "memory"); __builtin_amdgcn_s_barrier(); asm volatile("" ::: "memory");
        const bool first_of_seq = (u.pm & 15) == 0;
        const int ch0 = u.pn * HALF + tc0;
#pragma unroll
        for (int n = 0; n < 2; ++n) {
            f32x4 wg[3], wv[3], bg, bv;
#pragma unroll
            for (int t = 0; t < 3; ++t) { wg[t] = *(const f32x4*)(cw + t * 5632 + ch0 + 4 * n); wv[t] = *(const f32x4*)(cw + t * 5632 + 2816 + ch0 + 4 * n); }
            bg = *(const f32x4*)(cb + ch0 + 4 * n); bv = *(const f32x4*)(cb + 2816 + ch0 + 4 * n);
#pragma unroll
            for (int ai = 0; ai < 2; ++ai) {
                bf16_t* gp = G + (size_t)(u.pm * BM + ai * HALF + wr * 64 + 48 + fr) * 2816 + ch0 + 4 * n; asm volatile("" : "+v"(gp));
#pragma unroll
                for (int m = 3; m >= 0; --m) {
                    const f32x4 cg_ = acc[ai][0][m][n], cv_ = acc[ai][1][m][n];
                    f32x4 og1, og2, ov1, ov2;
                    if (m > 0) {
#pragma unroll
                        for (int j = 0; j < 4; ++j) { og1[j] = dpp_shl15(acc[ai][0][m - 1][n][j]); og2[j] = dpp_shl14(acc[ai][0][m - 1][n][j]); ov1[j] = dpp_shl15(acc[ai][1][m - 1][n][j]); ov2[j] = dpp_shl14(acc[ai][1][m - 1][n][j]); }
                    } else {
                        f32x4 hg1 = {0.f, 0.f, 0.f, 0.f}, hg2 = hg1, hv1 = hg1, hv2 = hg1;
#ifdef DBG_NOHALO
                        if (false) {
#else
                        if (fr < 2 && (ai + wr) > 0) {
#endif
                            const int pg = (wr == 1) ? (ai * 2) : 1;
                            PG8_LAS const float* hp = halo + pg * 2 * 256 + tc0 + 4 * n;
                            hg1 = *(PG8_LAS const f32x4*)(hp + 256); hv1 = *(PG8_LAS const f32x4*)(hp + 256 + HALF);
                            hg2 = *(PG8_LAS const f32x4*)(hp + fr * 256); hv2 = *(PG8_LAS const f32x4*)(hp + fr * 256 + HALF);
                        }
                        og1 = hg1; og2 = hg2; ov1 = hv1; ov2 = hv2; }
                    float r[4];
#pragma unroll
                    for (int j = 0; j < 4; ++j) {
#ifdef DBG_SHFL
                        const int l_ = fq * 16 + fr;
                        float g1 = __shfl(cg_[j], (l_ - 1) & 63), g2 = __shfl(cg_[j], (l_ - 2) & 63), v1 = __shfl(cv_[j], (l_ - 1) & 63), v2 = __shfl(cv_[j], (l_ - 2) & 63);
                        float pg1 = hg1[j], pg2 = hg2[j], pv1 = hv1[j], pv2 = hv2[j];
                        if (m > 0) { const float a_ = acc[ai][0][m > 0 ? m - 1 : 0][n][j], b_ = acc[ai][1][m > 0 ? m - 1 : 0][n][j];
                            pg1 = __shfl(a_, (l_ + 15) & 63); pg2 = __shfl(a_, (l_ + 14) & 63); pv1 = __shfl(b_, (l_ + 15) & 63); pv2 = __shfl(b_, (l_ + 14) & 63); }
                        if (fr < 1) { g1 = pg1; v1 = pv1; }
                        if (fr < 2) { g2 = pg2; v2 = pv2; }
#else
                        const float g1 = dpp_shr1(og1[j], cg_[j]), g2 = dpp_shr2(og2[j], cg_[j]);
                        const float v1 = dpp_shr1(ov1[j], cv_[j]), v2 = dpp_shr2(ov2[j], cv_[j]);
#endif
#ifdef DBG_NOPREV
                        const float yg = bg[j] + wg[2][j] * cg_[j]; const float yv = bv[j] + wv[2][j] * cv_[j]; (void)g1; (void)g2; (void)v1; (void)v2;
#else
#ifdef DBG_DROP
                        const float yg = bg[j] + ((DBG_DROP & 1) ? 0.f : wg[0][j] * g2) + ((DBG_DROP & 2) ? 0.f : wg[1][j] * g1) + wg[2][j] * cg_[j];
                        const float yv = bv[j] + ((DBG_DROP & 4) ? 0.f : wv[0][j] * v2) + ((DBG_DROP & 8) ? 0.f : wv[1][j] * v1) + wv[2][j] * cv_[j];
#else
                        const float yg = bg[j] + wg[0][j] * g2 + wg[1][j] * g1 + wg[2][j] * cg_[j];
                        const float yv = bv[j] + wv[0][j] * v2 + wv[1][j] * v1 + wv[2][j] * cv_[j];
#endif
#endif
                        r[j] = silu_f(yg) * yv;
#ifdef DBG_LINEAR
                        r[j] = cg_[j] + 0.5f * cv_[j];
#endif
#ifdef DBG_SILU_RAW
                        r[j] = silu_f(cg_[j]) * cv_[j];
#endif
#ifdef DBG_TAPS
                        r[j] = g1 + 0.5f * v1 + 0.25f * g2 + 0.125f * v2;
#endif
#ifdef DBG_WTS
                        r[j] = wg[0][j] + 2.f * wg[1][j] + 3.f * wv[0][j] + 4.f * wv[1][j];
#endif
#ifdef DBG_LINCONV
                        r[j] = yg + 0.5f * yv;
#endif
                    }
                    const unsigned p0 = cvt_pk_bf16(r[0], r[1]), p1 = cvt_pk_bf16(r[2], r[3]);
#ifdef NOHACK2
                    { const bool deferred = (ai == 0 && wr == 0 && m == 0 && fr < 2 && !first_of_seq);
                      if (!deferred) { u32x2 w2; w2.x = p0; w2.y = p1; *(u32x2*)gp = w2; }
                      gp -= 16 * 2816; asm volatile("" : "+v"(gp)); }
                    if (false) {
#elif defined(DBG_NOHACK)
                    { const int row = u.pm * BM + ai * HALF + wr * 64 + m * 16 + fr;
                      const bool deferred = (ai == 0 && wr == 0 && m == 0 && fr < 2 && !first_of_seq);
                      if (!deferred) { u32x2 w2; w2.x = p0; w2.y = p1; *(u32x2*)(G + (size_t)row * 2816 + ch0 + 4 * n) = w2; } }
                    if (false) {
#else
                    if (n == 0) { acc[ai][0][m][0][0] = __builtin_bit_cast(float, p0); acc[ai][0][m][0][1] = __builtin_bit_cast(float, p1); }
                    else {
#endif
                        const int row = u.pm * BM + ai * HALF + wr * 64 + m * 16 + fr;
#ifdef DBG_NOHALO
                        const bool deferred = false; (void)first_of_seq;
#else
                        const bool deferred = (ai == 0 && wr == 0 && m == 0 && fr < 2 && !first_of_seq);
#endif
                        if (!deferred) { u32x4 w; w.x = __builtin_bit_cast(unsigned, acc[ai][0][m][0][0]); w.y = __builtin_bit_cast(unsigned, acc[ai][0][m][0][1]); w.z = p0; w.w = p1;
                            *(u32x4*)(G + (size_t)row * 2816 + ch0) = w; }
                    }
                }
            }
        }
    }
};
struct EpiUpRaw {
    static constexpr bool PERM = true, AFTER_DRAIN = false;
    bf16_t* U; const float* rowss;
    __device__ __forceinline__ void operator()(const f32x4 (&acc)[2][2][4][2], const Unit& u, int wr, int wc, int fr, int fq) const {
        const int ch0 = u.pn * HALF + wc * 32 + 8 * fq;
#pragma unroll
        for (int ai = 0; ai < 2; ++ai)
#pragma unroll
            for (int m = 0; m < 4; ++m) { const int row = u.pm * BM + ai * HALF + wr * 64 + m * 16 + fr; const float rs = rsqrtf(rowss[row] * (1.0f / 1024.0f) + 1e-6f);
#pragma unroll
                for (int bj = 0; bj < 2; ++bj) { const f32x4 v0 = acc[ai][bj][m][0] * rs, v1 = acc[ai][bj][m][1] * rs;
                    u32x4 w; w.x = cvt_pk_bf16(v0[0], v0[1]); w.y = cvt_pk_bf16(v0[2], v0[3]); w.z = cvt_pk_bf16(v1[0], v1[1]); w.w = cvt_pk_bf16(v1[2], v1[3]);
                    *(u32x4*)(U + (size_t)row * 5632 + bj * 2816 + ch0) = w; } }
    }
};
struct EpiUp2 {
    static constexpr bool PERM = true, AFTER_DRAIN = false;
    bf16_t* G; float* EDGE; const float* rowss; const float* cw; const float* cb; PG8_LAS float* halo;
    __device__ __forceinline__ void operator()(f32x4 (&acc)[2][2][4][2], const Unit& u, int wr, int wc, int fr_in, int fq_in) const {
        int fr = fr_in, fq = fq_in; asm volatile("" : "+v"(fr), "+v"(fq));
#pragma unroll
        for (int ai = 0; ai < 2; ++ai)
#pragma unroll
            for (int m = 0; m < 4; ++m) { const float rs_ = rsqrtf(rowss[u.pm * BM + ai * HALF + wr * 64 + m * 16 + fr] * (1.0f / 1024.0f) + 1e-6f);
#pragma unroll
                for (int bj = 0; bj < 2; ++bj)
#pragma unroll
                    for (int n = 0; n < 2; ++n) acc[ai][bj][m][n] = acc[ai][bj][m][n] * rs_; }
        const int tc0 = wc * 32 + 8 * fq;
        if (fr >= 14) {
#pragma unroll
            for (int ai = 0; ai < 2; ++ai)
#pragma unroll
                for (int bj = 0; bj < 2; ++bj)
#pragma unroll
                    for (int n = 0; n < 2; ++n) { const f32x4 v = acc[ai][bj][3][n];
                        *(PG8_LAS f32x4*)(halo + ((ai * 2 + wr) * 2 + (fr - 14)) * 256 + bj * HALF + tc0 + 4 * n) = v;
                        if (ai == 1 && wr == 1) *(f32x4*)(EDGE + ((size_t)u.pm * 4 + 2 + (fr - 14)) * 5632 + u.pn * BM + bj * HALF + tc0 + 4 * n) = v; }
        }
        if (fr < 2 && wr == 0) {
#pragma unroll
            for (int bj = 0; bj < 2; ++bj)
#pragma unroll
                for (int n = 0; n < 2; ++n) *(f32x4*)(EDGE + ((size_t)u.pm * 4 + fr) * 5632 + u.pn * BM + bj * HALF + tc0 + 4 * n) = acc[0][bj][0][n];
        }
        asm volatile("s_waitcnt lgkmcnt(0)" ::: "memory"); __builtin_amdgcn_s_barrier(); asm volatile("" ::: "memory");
        const bool first_of_seq = (u.pm & 15) == 0;
        const int ch0 = u.pn * HALF + tc0;
#pragma unroll
        for (int n = 0; n < 2; ++n) {
            asm volatile("" ::: "memory");
            { f32x4 w0 = *(const f32x4*)(cw + ch0 + 4 * n), w1 = *(const f32x4*)(cw + 5632 + ch0 + 4 * n), w2 = *(const f32x4*)(cw + 2 * 5632 + ch0 + 4 * n), bb = *(const f32x4*)(cb + ch0 + 4 * n);
#pragma unroll
              for (int ai = 0; ai < 2; ++ai) {
                f32x4 o1 = {0.f, 0.f, 0.f, 0.f}, o2 = o1;
                if (fr < 2 && (ai + wr) > 0) { const int pgi = (wr == 1) ? (ai * 2) : 1; PG8_LAS const float* hp = halo + pgi * 2 * 256 + tc0 + 4 * n;
                    o1 = *(PG8_LAS const f32x4*)(hp + 256); o2 = *(PG8_LAS const f32x4*)(hp + fr * 256); }
#pragma unroll
                for (int m = 0; m < 4; ++m) { const f32x4 c_ = acc[ai][0][m][n]; f32x4 s_;
#pragma unroll
                    for (int j = 0; j < 4; ++j) { const float p1 = dpp_shr1(o1[j], c_[j]), p2 = dpp_shr2(o2[j], c_[j]);
                        s_[j] = silu_f(bb[j] + w0[j] * p2 + w1[j] * p1 + w2[j] * c_[j]); o1[j] = dpp_shl15(c_[j]); o2[j] = dpp_shl14(c_[j]); }
                    acc[ai][0][m][n] = s_; __builtin_amdgcn_sched_barrier(0); } } }
            asm volatile("" ::: "memory");
            { f32x4 w0 = *(const f32x4*)(cw + 2816 + ch0 + 4 * n), w1 = *(const f32x4*)(cw + 5632 + 2816 + ch0 + 4 * n), w2 = *(const f32x4*)(cw + 2 * 5632 + 2816 + ch0 + 4 * n), bb = *(const f32x4*)(cb + 2816 + ch0 + 4 * n);
#pragma unroll
              for (int ai = 0; ai < 2; ++ai) {
                f32x4 o1 = {0.f, 0.f, 0.f, 0.f}, o2 = o1;
                if (fr < 2 && (ai + wr) > 0) { const int pgi = (wr == 1) ? (ai * 2) : 1; PG8_LAS const float* hp = halo + pgi * 2 * 256 + HALF + tc0 + 4 * n;
                    o1 = *(PG8_LAS const f32x4*)(hp + 256); o2 = *(PG8_LAS const f32x4*)(hp + fr * 256); }
                bf16_t* gp = G + (size_t)(u.pm * BM + ai * HALF + wr * 64 + fr) * 2816 + ch0 + 4 * n; asm volatile("" : "+v"(gp));
#pragma unroll
                for (int m = 0; m < 4; ++m) { const f32x4 c_ = acc[ai][1][m][n]; const f32x4 sg = acc[ai][0][m][n]; float r[4];
#pragma unroll
                    for (int j = 0; j < 4; ++j) { const float p1 = dpp_shr1(o1[j], c_[j]), p2 = dpp_shr2(o2[j], c_[j]);
                        r[j] = sg[j] * (bb[j] + w0[j] * p2 + w1[j] * p1 + w2[j] * c_[j]); o1[j] = dpp_shl15(c_[j]); o2[j] = dpp_shl14(c_[j]); }
                    const bool deferred = (ai == 0 && wr == 0 && m == 0 && fr < 2 && !first_of_seq);
                    if (!deferred) { u32x2 w; w.x = cvt_pk_bf16(r[0], r[1]); w.y = cvt_pk_bf16(r[2], r[3]); *(u32x2*)gp = w; }
                    gp += 16 * 2816; asm volatile("" : "+v"(gp)); __builtin_amdgcn_sched_barrier(0); } } }
        }
    }
};
}


#define LAS __attribute__((address_space(3)))
typedef unsigned short bf16;
typedef float f32x4 __attribute__((ext_vector_type(4)));
typedef float f32x16 __attribute__((ext_vector_type(16)));
typedef short bf16x8 __attribute__((ext_vector_type(8)));
typedef short s16x4 __attribute__((ext_vector_type(4)));
typedef unsigned u32x4 __attribute__((ext_vector_type(4)));
typedef unsigned u32x2 __attribute__((ext_vector_type(2)));

constexpr int T = 32768, DM = 1024, SEQ = 4096, NBATCH = 8, PROJW = 3592, DFF = 2816;
constexpr int NWAVES = 8, NTHREADS = 512;
constexpr float EPS = 1e-6f;
constexpr size_t MiB = 1u << 20, KiB = 1u << 10;
constexpr size_t WS_ROWSS = 0, WS_ROWSS2 = 128 * KiB, WS_GATES = 256 * KiB  , WS_CHS = 1280 * KiB  , WS_MC = 1288 * KiB  ,
                 WS_DN = 1536 * KiB  , WS_NH = 2 * MiB  , WS_LSE = 3 * MiB  ;
constexpr size_t WS_BAR = 1408 * KiB  ;
constexpr size_t WS_WIN = 6 * MiB, WS_WOUT = 13 * MiB, WS_WUP = 15 * MiB, WS_WDOWN = 26 * MiB;
constexpr size_t WS_XN = 32 * MiB, WS_OG = 32 * MiB  , WS_H1B = 32 * MiB;
constexpr size_t WS_Y = 128 * MiB;
constexpr size_t WS_AQ = 192 * MiB, WS_AK = 224 * MiB, WS_AV = 256 * MiB, WS_MQR = 288 * MiB, WS_MKR = 320 * MiB, WS_MV = 352 * MiB, WS_MO = 384 * MiB;
constexpr size_t WS_CH = 288 * MiB  ;
constexpr size_t WS_MQ = 416 * MiB, WS_MK = 448 * MiB, WS_DC = 480 * MiB  ;
constexpr size_t WS_G = 192 * MiB  , WS_EDGE = 368 * MiB  ;
constexpr size_t WS_U = 96 * MiB  ;
constexpr size_t WS_END = 512 * MiB;
static_assert(WS_G + (size_t)T * DFF * 2 <= WS_EDGE && WS_EDGE + (size_t)128 * 4 * 5632 * 4 <= WS_MQ, "ws map");
#ifdef FFN_UNFUSED
constexpr size_t FFN_A = WS_U; constexpr int FFN_LDA = 5632;
#else
constexpr size_t FFN_A = WS_G; constexpr int FFN_LDA = DFF;
#endif
constexpr int LDS_BYTES = 147456;
constexpr int LDS_AUX = 131072;

__device__ __forceinline__ float bf2f(unsigned short v) { return __uint_as_float(((unsigned)v) << 16); }
__device__ __forceinline__ unsigned f2bf(float f) { unsigned u = __float_as_uint(f); return (u + 0x7fffu + ((u >> 16) & 1u)) >> 16; }
__device__ __forceinline__ unsigned pk2(float lo, float hi) { return f2bf(lo) | (f2bf(hi) << 16); }
__device__ __forceinline__ float wave_sum(float v) {
#pragma unroll
    for (int o = 1; o < 64; o <<= 1) v += __shfl_xor(v, o);
    return v;
}
__device__ __forceinline__ float wave_max(float v) {
#pragma unroll
    for (int o = 1; o < 64; o <<= 1) v = fmaxf(v, __shfl_xor(v, o));
    return v;
}
#define WG_SYNC() __syncthreads()
__device__ __forceinline__ int opaque_tid() { int t = threadIdx.x; asm volatile("" : "+v"(t)); return t; }

struct Args { const float* in[16]; float* out; unsigned char* ws; };
enum { I_X = 0, I_WIN, I_MCW, I_MCB, I_IB, I_FB, I_ANW, I_MNW, I_WOUT, I_MIXNW, I_FFNNW, I_WUP, I_FCW, I_FCB, I_WDOWN, I_FINW };

__device__ __forceinline__ void transpose_item(const float* W, int ldw, int K, bf16* WT, int dst_row0, int k0, int n0, const float* kscale, float* scr, int lane) {
#pragma unroll 8
    for (int i = 0; i < 32; ++i) { const int kk = 2 * i + (lane >> 5); float v = W[(size_t)(k0 + kk) * ldw + n0 + (lane & 31)]; if (kscale) v *= kscale[k0 + kk]; scr[kk * 33 + (lane & 31)] = v; }
    asm volatile("s_waitcnt lgkmcnt(0)" ::: "memory");
    const int c = lane & 7;
#pragma unroll
    for (int j = 0; j < 4; ++j) { const int n = (lane >> 3) + 8 * j; const float* s = scr + (8 * c) * 33 + n;
        u32x4 o; o.x = pk2(s[0 * 33], s[1 * 33]); o.y = pk2(s[2 * 33], s[3 * 33]); o.z = pk2(s[4 * 33], s[5 * 33]); o.w = pk2(s[6 * 33], s[7 * 33]);
        *(u32x4*)(WT + (size_t)(dst_row0 + n) * K + k0 + 8 * c) = o; }
    asm volatile("s_waitcnt lgkmcnt(0)" ::: "memory");
}

__device__ __forceinline__ void phase0(const Args& a, unsigned char* lds) {
    const int tid = opaque_tid(), lane = tid & 63, wave = tid >> 6;
    const int gw = blockIdx.x * NWAVES + wave, NGW = gridDim.x * NWAVES;
    unsigned char* ws = a.ws;
    float* scr = (float*)(lds + wave * 16384);
    constexpr int I_A = 16 * 112, I_B = 16 * 32, I_C = 16 * 176, I_D = 44 * 32, NITEMS = I_A + I_B + I_C + I_D;
    for (int it = gw; it < NITEMS; it += NGW) {
        int r = it;
        if (r < I_A) { const int kb = r / 112, nb = r % 112; transpose_item(a.in[I_WIN], PROJW, 1024, (bf16*)(ws + WS_WIN), 32 * nb, 64 * kb, 32 * nb, nullptr, scr, lane); continue; } r -= I_A;
        if (r < I_B) { const int kb = r / 32, nb = r % 32; transpose_item(a.in[I_WOUT], 1024, 1024, (bf16*)(ws + WS_WOUT), 32 * nb, 64 * kb, 32 * nb, nullptr, scr, lane); continue; } r -= I_B;
        if (r < I_C) { const int kb = r / 176, nb = r % 176; const int n0 = 32 * nb, bj = n0 >= DFF ? 1 : 0, c0 = n0 - DFF * bj; const int dst = 256 * (c0 >> 7) + 128 * bj + (c0 & 127);
            transpose_item(a.in[I_WUP], 2 * DFF, 1024, (bf16*)(ws + WS_WUP), dst, 64 * kb, n0, a.in[I_FFNNW], scr, lane); continue; } r -= I_C;
        { const int kb = r / 32, nb = r % 32; transpose_item(a.in[I_WDOWN], 1024, DFF, (bf16*)(ws + WS_WDOWN), 32 * nb, 64 * kb, 32 * nb, nullptr, scr, lane); }
    }
    { float* z = (float*)(ws + WS_ROWSS); for (int i = blockIdx.x * NTHREADS + tid; i < 2 * T; i += gridDim.x * NTHREADS) z[i] = 0.f; }
    const float* x = a.in[I_X]; const float* win = a.in[I_WIN];
    float gwt[16][8]; f32x4 nw[4];
#pragma unroll
    for (int j = 0; j < 4; ++j) { nw[j] = *(const f32x4*)(a.in[I_MIXNW] + 256 * j + 4 * lane);
#pragma unroll
        for (int e = 0; e < 4; ++e) { const float* p = win + (size_t)(256 * j + 4 * lane + e) * PROJW + 3584; const f32x4 g0 = *(const f32x4*)p, g1 = *(const f32x4*)(p + 4);
            gwt[j * 4 + e][0] = g0[0]; gwt[j * 4 + e][1] = g0[1]; gwt[j * 4 + e][2] = g0[2]; gwt[j * 4 + e][3] = g0[3]; gwt[j * 4 + e][4] = g1[0]; gwt[j * 4 + e][5] = g1[1]; gwt[j * 4 + e][6] = g1[2]; gwt[j * 4 + e][7] = g1[3]; } }
    const float gbias = lane < 4 ? a.in[I_IB][lane] : (lane < 8 ? a.in[I_FB][lane - 4] : 0.f);
    bf16* XN = (bf16*)(ws + WS_XN); float* GATES = (float*)(ws + WS_GATES);
    f32x4 vn[4];
    { const f32x4* xr = (const f32x4*)(x + (size_t)gw * DM) + lane;
#pragma unroll
      for (int j = 0; j < 4; ++j) vn[j] = xr[64 * j]; }
    for (int m = gw; m < T; m += NGW) {
        f32x4 v[4]; float s = 0.f;
#pragma unroll
        for (int j = 0; j < 4; ++j) { v[j] = vn[j]; s += (v[j][0] * v[j][0] + v[j][1] * v[j][1]) + (v[j][2] * v[j][2] + v[j][3] * v[j][3]); }
        { const int mn = (m + NGW < T) ? m + NGW : m; const f32x4* xr = (const f32x4*)(x + (size_t)mn * DM) + lane;
#pragma unroll
          for (int j = 0; j < 4; ++j) vn[j] = xr[64 * j]; }
        const float rstd = rsqrtf(wave_sum(s) * (1.0f / DM) + EPS);
        float gs[8] = {0.f, 0.f, 0.f, 0.f, 0.f, 0.f, 0.f, 0.f};
        unsigned long long* o8 = (unsigned long long*)(XN + (size_t)m * DM) + lane;
#pragma unroll
        for (int j = 0; j < 4; ++j) { v[j] = v[j] * rstd * nw[j];
            o8[64 * j] = (unsigned long long)pk2(v[j][0], v[j][1]) | ((unsigned long long)pk2(v[j][2], v[j][3]) << 32);
#pragma unroll
            for (int e = 0; e < 4; ++e)
#pragma unroll
                for (int g = 0; g < 8; ++g) gs[g] += v[j][e] * gwt[j * 4 + e][g]; }
        float h4[4], h2[2], mine;
        { const bool up = (lane & 32) != 0;
#pragma unroll
          for (int i = 0; i < 4; ++i) { const float keep = up ? gs[4 + i] : gs[i], send = up ? gs[i] : gs[4 + i]; h4[i] = keep + __shfl_xor(send, 32); } }
        { const bool up = (lane & 16) != 0;
#pragma unroll
          for (int i = 0; i < 2; ++i) { const float keep = up ? h4[2 + i] : h4[i], send = up ? h4[i] : h4[2 + i]; h2[i] = keep + __shfl_xor(send, 16); } }
        { const bool up = (lane & 8) != 0; const float keep = up ? h2[1] : h2[0], send = up ? h2[0] : h2[1]; mine = keep + __shfl_xor(send, 8); }
        mine += __shfl_xor(mine, 4); mine += __shfl_xor(mine, 2); mine += __shfl_xor(mine, 1);
        { const int src = ((lane & 4) ? 32 : 0) | ((lane & 2) ? 16 : 0) | ((lane & 1) ? 8 : 0); mine = __shfl(mine, src); }
        if (lane < 8) { float z = mine + gbias; if (lane >= 4) z = (z >= 0.f) ? -log1pf(__expf(-z)) : (z - log1pf(__expf(z))); GATES[(size_t)m * 8 + lane] = z; }
    }
}

constexpr int AQ_STRIDE = 144, AV_STRIDE = 528;
constexpr int A_QS = 0, A_KS = 128 * AQ_STRIDE, A_VT = A_KS + 256 * AQ_STRIDE;
struct AttnRegs { u32x4 q[2], k[4], v[4]; };
struct AttnIdx { int grp, dil, blk, h; size_t tok0; };
__device__ __forceinline__ AttnIdx attn_decode(int u) {
    AttnIdx x; x.grp = u >> 11; int v = u & 2047; x.dil = x.grp == 0 ? 1 : (x.grp == 1 ? 4 : 16); const int nb = 32 / x.dil;
    x.blk = v % nb; v /= nb; const int r = v % x.dil; v /= x.dil; x.h = v & 7; const int b = v >> 3; x.tok0 = (size_t)b * SEQ + r; return x;
}
__device__ __forceinline__ void attn_load(AttnRegs& R, const bf16* AQ, const bf16* AK, const bf16* AV, int u, int tid) {
    const AttnIdx x = attn_decode(u);
#pragma unroll
    for (int i = 0; i < 2; ++i) { const int idx = tid + 512 * i, row = idx >> 3, ch = idx & 7; const size_t tok = x.tok0 + (size_t)(x.blk * 128 + row) * x.dil;
        R.q[i] = *(const u32x4*)(AQ + tok * 512 + x.h * 64 + ch * 8); }
#pragma unroll
    for (int i = 0; i < 4; ++i) { const int idx = tid + 512 * i, row = idx >> 3, ch = idx & 7; const int isub = (x.blk - 1) * 128 + row;
        u32x4 kv = {0u, 0u, 0u, 0u};
        if (isub >= 0) { const size_t tok = x.tok0 + (size_t)isub * x.dil; kv = *(const u32x4*)(AK + tok * 512 + x.h * 64 + ch * 8); }
        R.k[i] = kv; }
#pragma unroll
    for (int i = 0; i < 2; ++i) { const int idx = tid + 512 * i, rp = idx >> 3, ch = idx & 7;
#pragma unroll
        for (int q = 0; q < 2; ++q) { const int isub = (x.blk - 1) * 128 + 2 * rp + q; u32x4 vv = {0u, 0u, 0u, 0u};
            if (isub >= 0) { const size_t tok = x.tok0 + (size_t)isub * x.dil; vv = *(const u32x4*)(AV + tok * 512 + x.h * 64 + ch * 8); }
            R.v[2 * i + q] = vv; } }
}
__device__ __forceinline__ void attn_stage(const AttnRegs& R, unsigned char* lds, int tid) {
#pragma unroll
    for (int i = 0; i < 2; ++i) { const int idx = tid + 512 * i, row = idx >> 3, ch = idx & 7; *(u32x4*)(lds + A_QS + row * AQ_STRIDE + ch * 16) = R.q[i]; }
#pragma unroll
    for (int i = 0; i < 4; ++i) { const int idx = tid + 512 * i, row = idx >> 3, ch = idx & 7; *(u32x4*)(lds + A_KS + row * AQ_STRIDE + ch * 16) = R.k[i]; }
#pragma unroll
    for (int i = 0; i < 2; ++i) { const int idx = tid + 512 * i, rp = idx >> 3, ch = idx & 7; const u32x4 a = R.v[2 * i], c = R.v[2 * i + 1];
        unsigned* vt = (unsigned*)(lds + A_VT + (ch * 8) * AV_STRIDE + rp * 4);
#pragma unroll
        for (int wd = 0; wd < 4; ++wd) { vt[(2 * wd) * (AV_STRIDE / 4)] = (a[wd] & 0xffffu) | (c[wd] << 16); vt[(2 * wd + 1) * (AV_STRIDE / 4)] = (a[wd] >> 16) | (c[wd] & 0xffff0000u); } }
}
__device__ __forceinline__ void attn_compute(unsigned char* lds, bf16* OG, float* LSE, int u, const int tid) {
    const int lane = tid & 63, w = tid >> 6, l15 = lane & 15, g4 = lane >> 4;
    const AttnIdx x = attn_decode(u); const int grp = x.grp, dil = x.dil, blk = x.blk, h = x.h; const size_t tok0 = x.tok0;
    bf16x8 qf[2];
#pragma unroll
    for (int ks = 0; ks < 2; ++ks) qf[ks] = *(const bf16x8*)(lds + A_QS + (16 * w + l15) * AQ_STRIDE + ks * 64 + g4 * 16);
    f32x4 sc[9];
#pragma unroll
    for (int n = 0; n < 9; ++n) { f32x4 acc = {0.f, 0.f, 0.f, 0.f};
#pragma unroll
        for (int ks = 0; ks < 2; ++ks) { const bf16x8 kf = *(const bf16x8*)(lds + A_KS + (16 * (w + n) + l15) * AQ_STRIDE + ks * 64 + g4 * 16);
            acc = __builtin_amdgcn_mfma_f32_16x16x32_bf16(kf, qf[ks], acc, 0, 0, 0); }
        sc[n] = acc; }
    float mx = -INFINITY;
#pragma unroll
    for (int n = 0; n < 9; ++n)
#pragma unroll
        for (int j = 0; j < 4; ++j) { const int dk = 16 * n + 4 * g4 + j - l15; const int kj = 16 * (w + n) + 4 * g4 + j;
            const bool ok = (dk >= 0) && (dk <= 128) && (blk > 0 || kj >= 128);
            sc[n][j] = ok ? sc[n][j] : -INFINITY; mx = fmaxf(mx, sc[n][j]); }
    mx = fmaxf(mx, __shfl_xor(mx, 16)); mx = fmaxf(mx, __shfl_xor(mx, 32));
    float den = 0.f;
#pragma unroll
    for (int n = 0; n < 9; ++n)
#pragma unroll
        for (int j = 0; j < 4; ++j) { const float p = __expf(sc[n][j] - mx); sc[n][j] = p; den += p; }
    den += __shfl_xor(den, 16); den += __shfl_xor(den, 32);
    f32x4 o[4];
#pragma unroll
    for (int dt = 0; dt < 4; ++dt) o[dt] = (f32x4){0.f, 0.f, 0.f, 0.f};
#pragma unroll
    for (int s = 0; s < 5; ++s) {
        u32x4 pw; pw.x = pk2(sc[2 * s][0], sc[2 * s][1]); pw.y = pk2(sc[2 * s][2], sc[2 * s][3]);
        if (s < 4) { pw.z = pk2(sc[2 * s + 1][0], sc[2 * s + 1][1]); pw.w = pk2(sc[2 * s + 1][2], sc[2 * s + 1][3]); } else { pw.z = 0u; pw.w = 0u; }
        const bf16x8 pf = __builtin_bit_cast(bf16x8, pw);
        const int t0 = w + 2 * s; int t1 = w + 2 * s + 1; t1 = t1 > 15 ? 15 : t1;
#pragma unroll
        for (int dt = 0; dt < 4; ++dt) { const unsigned char* vrow = lds + A_VT + (16 * dt + l15) * AV_STRIDE + g4 * 8;
            u32x4 vw; const u32x2 lo = *(const u32x2*)(vrow + t0 * 32), hi = *(const u32x2*)(vrow + t1 * 32); vw.x = lo.x; vw.y = lo.y; vw.z = hi.x; vw.w = hi.y;
            o[dt] = __builtin_amdgcn_mfma_f32_16x16x32_bf16(__builtin_bit_cast(bf16x8, vw), pf, o[dt], 0, 0, 0); }
    }
    const float rden = 1.0f / den;
    const size_t tokq = tok0 + (size_t)(blk * 128 + 16 * w + l15) * dil;
    bf16* op = OG + ((size_t)grp * T + tokq) * 512 + h * 64 + 4 * g4;
#pragma unroll
    for (int dt = 0; dt < 4; ++dt) { u32x2 ov; ov.x = pk2(o[dt][0] * rden, o[dt][1] * rden); ov.y = pk2(o[dt][2] * rden, o[dt][3] * rden); *(u32x2*)(op + 16 * dt) = ov; }
    if (g4 == 0) LSE[((size_t)grp * T + tokq) * 8 + h] = mx + __logf(den);
}

__device__ __forceinline__ void attn_combine(const Args& a) {
    const int tid = opaque_tid(), lane = tid & 63, wave = tid >> 6;
    const int gw = blockIdx.x * NWAVES + wave, NGW = gridDim.x * NWAVES;
    const bf16* OG = (const bf16*)(a.ws + WS_OG); const float* LSE = (const float*)(a.ws + WS_LSE); bf16* Y = (bf16*)(a.ws + WS_Y);
    const int h = lane >> 3;
    const f32x4 nw0 = *(const f32x4*)(a.in[I_ANW] + 8 * lane), nw1 = *(const f32x4*)(a.in[I_ANW] + 8 * lane + 4);
    float lsn[3]; u32x4 ovn[3];
#pragma unroll
    for (int g = 0; g < 3; ++g) { lsn[g] = LSE[((size_t)g * T + gw) * 8 + h]; ovn[g] = *(const u32x4*)(OG + ((size_t)g * T + gw) * 512 + 8 * lane); }
    for (int t = gw; t < T; t += NGW) {
        float ls[3]; u32x4 ov[3];
#pragma unroll
        for (int g = 0; g < 3; ++g) { ls[g] = lsn[g]; ov[g] = ovn[g]; }
        { const int tn = (t + NGW < T) ? t + NGW : t;
#pragma unroll
          for (int g = 0; g < 3; ++g) { lsn[g] = LSE[((size_t)g * T + tn) * 8 + h]; ovn[g] = *(const u32x4*)(OG + ((size_t)g * T + tn) * 512 + 8 * lane); } }
        const float mm = fmaxf(ls[0], fmaxf(ls[1], ls[2]));
        float wt[3]; float sw = 0.f;
#pragma unroll
        for (int g = 0; g < 3; ++g) { wt[g] = __expf(ls[g] - mm); sw += wt[g]; }
        const float isw = 1.0f / sw;
        float val[8]; float ss = 0.f;
#pragma unroll
        for (int e = 0; e < 8; ++e) { float acc = 0.f;
#pragma unroll
            for (int g = 0; g < 3; ++g) { const unsigned wd = ov[g][e >> 1]; const float f = (e & 1) ? __uint_as_float(wd & 0xffff0000u) : __uint_as_float(wd << 16); acc += wt[g] * f; }
            val[e] = acc * isw; ss += val[e] * val[e]; }
        ss += __shfl_xor(ss, 1); ss += __shfl_xor(ss, 2); ss += __shfl_xor(ss, 4);
        const float rs = rsqrtf(ss * (1.0f / 64.0f) + EPS);
        u32x4 ow; ow.x = pk2(val[0] * rs * nw0[0], val[1] * rs * nw0[1]); ow.y = pk2(val[2] * rs * nw0[2], val[3] * rs * nw0[3]);
        ow.z = pk2(val[4] * rs * nw1[0], val[5] * rs * nw1[1]); ow.w = pk2(val[6] * rs * nw1[2], val[7] * rs * nw1[3]);
        *(u32x4*)(Y + (size_t)t * DM + 8 * lane) = ow;
    }
}

__device__ __forceinline__ int toff(int row, int chunk) { return row * 272 + (chunk << 4); }
constexpr int M_T0 = 0, M_T1 = 34816, M_T2 = 69632, M_T3 = 104448, M_AUX = 139264;
__device__ __forceinline__ float scan_add(float v, int lane) {
#pragma unroll
    for (int o = 1; o < 64; o <<= 1) { const float t = __shfl_up(v, o); if (lane >= o) v += t; }
    return v;
}
__device__ __forceinline__ float scan_max(float v, int lane) {
#pragma unroll
    for (int o = 1; o < 64; o <<= 1) { const float t = __shfl_up(v, o); if (lane >= o) v = fmaxf(v, t); }
    return v;
}
__device__ __forceinline__ void unpack8(const u32x4& v, float* f) {
#pragma unroll
    for (int e = 0; e < 4; ++e) { f[2 * e] = __uint_as_float(v[e] << 16); f[2 * e + 1] = __uint_as_float(v[e] & 0xffff0000u); }
}

__device__ __forceinline__ void mlstm_a(const Args& a, unsigned char* lds, int unit, const int tid) {
    const int lane = tid & 63, w = tid >> 6, l31 = lane & 31, hh = lane >> 5;
    const int c = unit & 31, h = (unit >> 5) & 3, b = unit >> 7;
    const size_t t0 = (size_t)b * SEQ + 128 * c;
    unsigned char* ws = a.ws;
    const float* GATES = (const float*)(ws + WS_GATES);
    float* wS = (float*)(lds + M_AUX);
    if (w == 0) {
        const float li0 = GATES[(t0 + 2 * lane) * 8 + h], li1 = GATES[(t0 + 2 * lane + 1) * 8 + h];
        const float lf0 = GATES[(t0 + 2 * lane) * 8 + 4 + h], lf1 = GATES[(t0 + 2 * lane + 1) * 8 + 4 + h];
        const float inc = scan_add(lf0 + lf1, lane); const float b1 = inc, b0 = inc - lf1;
        const float gtot = __shfl(inc, 63);
        const float a0 = gtot - b0 + li0, a1 = gtot - b1 + li1;
        const float amax = wave_max(fmaxf(a0, a1));
        wS[2 * lane] = __expf(a0 - amax); wS[2 * lane + 1] = __expf(a1 - amax);
        if (lane == 0) { float* chs = (float*)(ws + WS_CHS); chs[unit * 2] = gtot; chs[unit * 2 + 1] = amax; }
    }
    {
        const int cgi = tid & 31, rg = tid >> 5; const bool isk = cgi >= 16; const int chl = 8 * (cgi & 15);
        const bf16* src = (const bf16*)(ws + (isk ? WS_MKR : WS_MQR)) + h * 128 + chl;
        bf16* dst = (bf16*)(ws + (isk ? WS_MK : WS_MQ)) + h * 128 + chl;
        const float* cwp = a.in[I_MCW] + (isk ? 512 : 0) + h * 128 + chl; const float* cbp = a.in[I_MCB] + (isk ? 512 : 0) + h * 128 + chl;
        float wt[4][8], bs[8];
#pragma unroll
        for (int t = 0; t < 4; ++t) { const f32x4 w0 = *(const f32x4*)(cwp + t * 1024), w1 = *(const f32x4*)(cwp + t * 1024 + 4);
#pragma unroll
            for (int e = 0; e < 4; ++e) { wt[t][e] = w0[e]; wt[t][4 + e] = w1[e]; } }
        { const f32x4 b0 = *(const f32x4*)cbp, b1 = *(const f32x4*)(cbp + 4);
#pragma unroll
          for (int e = 0; e < 4; ++e) { bs[e] = b0[e]; bs[4 + e] = b1[e]; } }
        float xw[3][8];
#pragma unroll
        for (int p = 0; p < 3; ++p) { const int rr = 8 * rg - 3 + p; const bool ok = (c > 0) || (rr >= 0);
            u32x4 raw = {0u, 0u, 0u, 0u}; if (ok) raw = *(const u32x4*)(src + (size_t)((long)t0 + rr) * 512); unpack8(raw, xw[p]); }
        unsigned ktp[8][4];
#pragma unroll
        for (int i = 0; i < 8; ++i) { const int rr = 8 * rg + i; float xc[8]; { const u32x4 raw = *(const u32x4*)(src + (t0 + rr) * 512); unpack8(raw, xc); }
            float y[8];
#pragma unroll
            for (int e = 0; e < 8; ++e) { float s = bs[e] + wt[0][e] * xw[0][e] + wt[1][e] * xw[1][e] + wt[2][e] * xw[2][e] + wt[3][e] * xc[e]; s = pg8::silu_f(s); if (isk) s *= 0.08838834764831845f; y[e] = s;
                xw[0][e] = xw[1][e]; xw[1][e] = xw[2][e]; xw[2][e] = xc[e]; }
            u32x4 ov; ov.x = pk2(y[0], y[1]); ov.y = pk2(y[2], y[3]); ov.z = pk2(y[4], y[5]); ov.w = pk2(y[6], y[7]);
            *(u32x4*)(dst + (t0 + rr) * 512) = ov;
#pragma unroll
            for (int e = 0; e < 8; ++e) { if (i & 1) ktp[e][i >> 1] |= f2bf(y[e]) << 16; else ktp[e][i >> 1] = f2bf(y[e]); } }
        if (isk) {
#pragma unroll
            for (int e = 0; e < 8; ++e) { u32x4 pw; pw.x = ktp[e][0]; pw.y = ktp[e][1]; pw.z = ktp[e][2]; pw.w = ktp[e][3];
                *(u32x4*)(lds + M_T0 + toff(chl + e, rg)) = pw; }
        }
    }
    WG_SYNC();
    {
        const int vcg = tid & 15, vrg = tid >> 4; const bf16* src = (const bf16*)(ws + WS_MV) + h * 128 + 8 * vcg;
        float vv[4][8];
#pragma unroll
        for (int i = 0; i < 4; ++i) { const int rr = 4 * vrg + i; const u32x4 raw = *(const u32x4*)(src + (t0 + rr) * 512); unpack8(raw, vv[i]); const float sc = wS[rr];
#pragma unroll
            for (int e = 0; e < 8; ++e) vv[i][e] *= sc; }
#pragma unroll
        for (int e = 0; e < 8; ++e) { u32x2 pw; pw.x = pk2(vv[0][e], vv[1][e]); pw.y = pk2(vv[2][e], vv[3][e]);
            *(u32x2*)(lds + M_T1 + toff(8 * vcg + e, vrg >> 1) + (vrg & 1) * 8) = pw; }
    }
    if (tid < 128) { float acc = 0.f;
#pragma unroll 4
        for (int ch = 0; ch < 16; ++ch) { float f[8]; const u32x4 raw = *(const u32x4*)(lds + M_T0 + toff(tid, ch)); unpack8(raw, f);
#pragma unroll
            for (int e = 0; e < 8; ++e) acc += f[e] * wS[8 * ch + e]; }
        ((float*)(ws + WS_DN))[(size_t)unit * 128 + tid] = acc; }
    WG_SYNC();
    {
        const int vt = w >> 1; f32x16 acc[2];
#pragma unroll
        for (int i = 0; i < 2; ++i)
#pragma unroll
            for (int r = 0; r < 16; ++r) acc[i][r] = 0.f;
#pragma unroll
        for (int ks = 0; ks < 8; ++ks) { const bf16x8 af = *(const bf16x8*)(lds + M_T1 + toff(32 * vt + l31, 2 * ks + hh));
#pragma unroll
            for (int i = 0; i < 2; ++i) { const int ktile = 2 * (w & 1) + i; const bf16x8 bfr = *(const bf16x8*)(lds + M_T0 + toff(32 * ktile + l31, 2 * ks + hh));
                acc[i] = __builtin_amdgcn_mfma_f32_32x32x16_bf16(af, bfr, acc[i], 0, 0, 0); } }
#pragma unroll
        for (int i = 0; i < 2; ++i) { const int kcol = 32 * (2 * (w & 1) + i) + l31; unsigned char* sp = lds + M_T2 + toff(32 * vt + 4 * hh, kcol >> 3) + (kcol & 7) * 2;
#pragma unroll
            for (int r = 0; r < 16; ++r) *(unsigned short*)(sp + ((r & 3) + 8 * (r >> 2)) * 272) = (unsigned short)f2bf(acc[i][r]); }
    }
    WG_SYNC();
    { bf16* DC = (bf16*)(ws + WS_DC) + (size_t)unit * 16384;
#pragma unroll
      for (int i = 0; i < 4; ++i) { const int idx = tid + 512 * i, row = idx >> 4, ch = idx & 15; *(u32x4*)(DC + row * 128 + 8 * ch) = *(const u32x4*)(lds + M_T2 + toff(row, ch)); } }
    WG_SYNC();
}

__device__ __forceinline__ void mlstm_scan(const Args& a) {
    const int gt = blockIdx.x * NTHREADS + opaque_tid(), NT = gridDim.x * NTHREADS;
    unsigned char* ws = a.ws;
    const float* chs = (const float*)(ws + WS_CHS);
    for (int idx = gt; idx < 32 * 4096; idx += NT) {
        const int bh = idx >> 12, e4 = (idx & 4095) * 4;
        const bf16* DC = (const bf16*)(ws + WS_DC) + (size_t)bh * 32 * 16384 + e4; bf16* CH = (bf16*)(ws + WS_CH) + (size_t)bh * 32 * 16384 + e4;
        float cur[4] = {0.f, 0.f, 0.f, 0.f}; float M = 0.f;
#pragma unroll 4
        for (int c = 0; c < 32; ++c) {
            const u32x2 raw = *(const u32x2*)(DC + (size_t)c * 16384);
            u32x2 o; o.x = pk2(cur[0], cur[1]); o.y = pk2(cur[2], cur[3]); *(u32x2*)(CH + (size_t)c * 16384) = o;
            const float g = chs[(bh * 32 + c) * 2], am = chs[(bh * 32 + c) * 2 + 1];
            const float Mn = fmaxf(g + M, am); const float dec = __expf(g + M - Mn), sc = __expf(am - Mn);
            cur[0] = dec * cur[0] + sc * __uint_as_float(raw.x << 16); cur[1] = dec * cur[1] + sc * __uint_as_float(raw.x & 0xffff0000u);
            cur[2] = dec * cur[2] + sc * __uint_as_float(raw.y << 16); cur[3] = dec * cur[3] + sc * __uint_as_float(raw.y & 0xffff0000u);
            M = Mn;
        }
    }
    for (int idx = gt; idx < 32 * 128; idx += NT) {
        const int bh = idx >> 7, k = idx & 127;
        const float* DN = (const float*)(ws + WS_DN) + (size_t)bh * 32 * 128 + k; float* NH = (float*)(ws + WS_NH) + (size_t)bh * 32 * 128 + k; float* MC = (float*)(ws + WS_MC) + bh * 32;
        float cur = 0.f, M = 0.f;
        for (int c = 0; c < 32; ++c) {
            NH[c * 128] = cur; if (k == 0) MC[c] = M;
            const float g = chs[(bh * 32 + c) * 2], am = chs[(bh * 32 + c) * 2 + 1];
            const float Mn = fmaxf(g + M, am); cur = __expf(g + M - Mn) * cur + __expf(am - Mn) * DN[c * 128]; M = Mn;
        }
    }
}

__device__ __forceinline__ void mlstm_c(const Args& a, unsigned char* lds, int unit, const int tid) {
    const int lane = tid & 63, w = tid >> 6, l31 = lane & 31, hh = lane >> 5;
    const int c = unit & 31, h = (unit >> 5) & 3, b = unit >> 7;
    const size_t t0 = (size_t)b * SEQ + 128 * c;
    unsigned char* ws = a.ws;
    const float* GATES = (const float*)(ws + WS_GATES);
    float* uS = (float*)(lds + M_AUX);
    float* mxS = uS + 128;
    float* bS = uS + 256;
    float* nhS = uS + 384;
    float* rdS = uS + 512;
    const float Mc = ((const float*)(ws + WS_MC))[unit];
    if (w == 0) {
        const float li0 = GATES[(t0 + 2 * lane) * 8 + h], li1 = GATES[(t0 + 2 * lane + 1) * 8 + h];
        const float lf0 = GATES[(t0 + 2 * lane) * 8 + 4 + h], lf1 = GATES[(t0 + 2 * lane + 1) * 8 + 4 + h];
        const float inc = scan_add(lf0 + lf1, lane); const float b1 = inc, b0 = inc - lf1;
        const float u0 = li0 - b0, u1 = li1 - b1;
        const float pm = scan_max(fmaxf(u0, u1), lane); float pprev = __shfl_up(pm, 1); if (lane == 0) pprev = -INFINITY;
        const float pm0 = fmaxf(pprev, u0), pm1 = pm;
        uS[2 * lane] = u0; uS[2 * lane + 1] = u1; mxS[2 * lane] = fmaxf(Mc, pm0); mxS[2 * lane + 1] = fmaxf(Mc, pm1); bS[2 * lane] = b0; bS[2 * lane + 1] = b1;
    }
    if (w == 1) { nhS[lane] = ((const float*)(ws + WS_NH))[(size_t)unit * 128 + lane]; nhS[64 + lane] = ((const float*)(ws + WS_NH))[(size_t)unit * 128 + 64 + lane]; }
    {
        const bf16* MQ = (const bf16*)(ws + WS_MQ) + h * 128; const bf16* MK = (const bf16*)(ws + WS_MK) + h * 128; const bf16* CH = (const bf16*)(ws + WS_CH) + (size_t)unit * 16384;
#pragma unroll
        for (int i = 0; i < 4; ++i) { const int idx = tid + 512 * i, row = idx >> 4, ch = idx & 15;
            *(u32x4*)(lds + M_T0 + toff(row, ch)) = *(const u32x4*)(MQ + (t0 + row) * 512 + 8 * ch);
            *(u32x4*)(lds + M_T1 + toff(row, ch)) = *(const u32x4*)(MK + (t0 + row) * 512 + 8 * ch);
            *(u32x4*)(lds + M_T3 + toff(row, ch)) = *(const u32x4*)(CH + row * 128 + 8 * ch); }
        const int vcg = tid & 15, vrg = tid >> 4; const bf16* src = (const bf16*)(ws + WS_MV) + h * 128 + 8 * vcg;
        u32x4 raw[4];
#pragma unroll
        for (int i = 0; i < 4; ++i) raw[i] = *(const u32x4*)(src + (t0 + 4 * vrg + i) * 512);
#pragma unroll
        for (int e = 0; e < 8; ++e) { const int wd = e >> 1; u32x2 pw;
            if (e & 1) { pw.x = (raw[0][wd] >> 16) | (raw[1][wd] & 0xffff0000u); pw.y = (raw[2][wd] >> 16) | (raw[3][wd] & 0xffff0000u); }
            else { pw.x = (raw[0][wd] & 0xffffu) | (raw[1][wd] << 16); pw.y = (raw[2][wd] & 0xffffu) | (raw[3][wd] << 16); }
            *(u32x2*)(lds + M_T2 + toff(8 * vcg + e, vrg >> 1) + (vrg & 1) * 8) = pw; }
    }
    WG_SYNC();
    const int ti = w >> 1;
    f32x16 sacc[2];
#pragma unroll
    for (int i = 0; i < 2; ++i) {
#pragma unroll
        for (int r = 0; r < 16; ++r) sacc[i][r] = 0.f;
        const int si = 2 * (w & 1) + i;
        if (si <= ti) {
#pragma unroll
            for (int ks = 0; ks < 8; ++ks) { const bf16x8 af = *(const bf16x8*)(lds + M_T0 + toff(32 * ti + l31, 2 * ks + hh)); const bf16x8 bfr = *(const bf16x8*)(lds + M_T1 + toff(32 * si + l31, 2 * ks + hh));
                sacc[i] = __builtin_amdgcn_mfma_f32_32x32x16_bf16(af, bfr, sacc[i], 0, 0, 0); }
        }
    }
    WG_SYNC();
#pragma unroll
    for (int i = 0; i < 2; ++i) { const int si = 2 * (w & 1) + i;
        if (si <= ti) { const int s = 32 * si + l31; const float us = uS[s];
#pragma unroll
            for (int r = 0; r < 16; ++r) { const int t = 32 * ti + (r & 3) + 8 * (r >> 2) + 4 * hh; const float p = (s <= t) ? sacc[i][r] * __expf(us - mxS[t]) : 0.f;
                *(unsigned short*)(lds + M_T1 + toff(t, s >> 3) + (s & 7) * 2) = (unsigned short)f2bf(p); } } }
    WG_SYNC();
    { const int t = tid >> 2, part = tid & 3, tb = t >> 5; float rsum = 0.f, qn = 0.f;
        for (int ch = part; ch < 4 * (tb + 1); ch += 4) { float f[8]; const u32x4 raw = *(const u32x4*)(lds + M_T1 + toff(t, ch)); unpack8(raw, f);
#pragma unroll
            for (int e = 0; e < 8; ++e) rsum += f[e]; }
        const float inter = __expf(Mc - mxS[t]);
#pragma unroll
        for (int c4 = 0; c4 < 4; ++c4) { const int ch = 4 * part + c4; float f[8]; const u32x4 raw = *(const u32x4*)(lds + M_T0 + toff(t, ch)); unpack8(raw, f);
#pragma unroll
            for (int e = 0; e < 8; ++e) { qn += f[e] * nhS[8 * ch + e]; f[e] *= inter; }
            u32x4 ov; ov.x = pk2(f[0], f[1]); ov.y = pk2(f[2], f[3]); ov.z = pk2(f[4], f[5]); ov.w = pk2(f[6], f[7]); *(u32x4*)(lds + M_T0 + toff(t, ch)) = ov; }
        rsum += __shfl_xor(rsum, 1); rsum += __shfl_xor(rsum, 2); qn += __shfl_xor(qn, 1); qn += __shfl_xor(qn, 2);
        const float den = rsum + inter * qn; const float mt = bS[t] + mxS[t];
        if (part == 0) rdS[t] = 1.0f / fmaxf(fabsf(den), __expf(-mt)); }
    WG_SYNC();
    f32x16 hacc[2];
#pragma unroll
    for (int i = 0; i < 2; ++i)
#pragma unroll
        for (int r = 0; r < 16; ++r) hacc[i][r] = 0.f;
    for (int ks = 0; ks < 2 * (ti + 1); ++ks) { const bf16x8 af = *(const bf16x8*)(lds + M_T1 + toff(32 * ti + l31, 2 * ks + hh));
#pragma unroll
        for (int i = 0; i < 2; ++i) { const int vt = 2 * (w & 1) + i; const bf16x8 bfr = *(const bf16x8*)(lds + M_T2 + toff(32 * vt + l31, 2 * ks + hh));
            hacc[i] = __builtin_amdgcn_mfma_f32_32x32x16_bf16(af, bfr, hacc[i], 0, 0, 0); } }
#pragma unroll
    for (int ks = 0; ks < 8; ++ks) { const bf16x8 af = *(const bf16x8*)(lds + M_T0 + toff(32 * ti + l31, 2 * ks + hh));
#pragma unroll
        for (int i = 0; i < 2; ++i) { const int vt = 2 * (w & 1) + i; const bf16x8 bfr = *(const bf16x8*)(lds + M_T3 + toff(32 * vt + l31, 2 * ks + hh));
            hacc[i] = __builtin_amdgcn_mfma_f32_32x32x16_bf16(af, bfr, hacc[i], 0, 0, 0); } }
    WG_SYNC();
    float* hS = (float*)lds;
#pragma unroll
    for (int i = 0; i < 2; ++i) { const int v = 32 * (2 * (w & 1) + i) + l31;
#pragma unroll
        for (int r = 0; r < 16; ++r) { const int t = 32 * ti + (r & 3) + 8 * (r >> 2) + 4 * hh; hS[t * 132 + v] = hacc[i][r] * rdS[t]; } }
    WG_SYNC();
    { const int t = tid >> 2, part = tid & 3; float hv[32]; float ss = 0.f;
#pragma unroll
        for (int q = 0; q < 8; ++q) { const f32x4 x4 = *(const f32x4*)(hS + t * 132 + 32 * part + 4 * q); hv[4 * q] = x4[0]; hv[4 * q + 1] = x4[1]; hv[4 * q + 2] = x4[2]; hv[4 * q + 3] = x4[3];
            ss += (x4[0] * x4[0] + x4[1] * x4[1]) + (x4[2] * x4[2] + x4[3] * x4[3]); }
        ss += __shfl_xor(ss, 1); ss += __shfl_xor(ss, 2);
        const float rs = rsqrtf(ss * (1.0f / 128.0f) + EPS);
        const float* nw = a.in[I_MNW] + h * 128 + 32 * part; const bf16* MO = (const bf16*)(ws + WS_MO) + (t0 + t) * 512 + h * 128 + 32 * part;
        bf16* Y = (bf16*)(ws + WS_Y) + (t0 + t) * DM + 512 + h * 128 + 32 * part;
#pragma unroll
        for (int q = 0; q < 4; ++q) { float og[8]; const u32x4 raw = *(const u32x4*)(MO + 8 * q); unpack8(raw, og); const f32x4 n0 = *(const f32x4*)(nw + 8 * q), n1 = *(const f32x4*)(nw + 8 * q + 4);
            float r8[8];
#pragma unroll
            for (int e = 0; e < 8; ++e) { const float nwv = e < 4 ? n0[e] : n1[e - 4]; const float sg = __builtin_amdgcn_rcpf(1.0f + __expf(-og[e])); r8[e] = hv[8 * q + e] * rs * nwv * sg;
#ifdef DBG_ZERO_ML
                r8[e] = 0.f;
#endif
            }
            u32x4 ov; ov.x = pk2(r8[0], r8[1]); ov.y = pk2(r8[2], r8[3]); ov.z = pk2(r8[4], r8[5]); ov.w = pk2(r8[6], r8[7]); *(u32x4*)(Y + 8 * q) = ov; } }
    WG_SYNC();
}

__device__ __forceinline__ void ffn_fixup(const Args& a) {
    const int gt = blockIdx.x * NTHREADS + opaque_tid(), NT = gridDim.x * NTHREADS;
    const float* EDGE = (const float*)(a.ws + WS_EDGE); bf16* G = (bf16*)(a.ws + WS_G); const float* cw = a.in[I_FCW]; const float* cb = a.in[I_FCB];
    for (int idx = gt; idx < 128 * 2 * DFF; idx += NT) {
        const int ch = idx % DFF; const int rr = (idx / DFF) & 1; const int pm = idx / (2 * DFF);
        if ((pm & 15) == 0) continue;
        const int tcg = 256 * (ch >> 7) + (ch & 127), tcv = tcg + 128;
        const float* e_cur = EDGE + ((size_t)pm * 4 + rr) * 5632; const float* e_p1 = rr ? EDGE + ((size_t)pm * 4 + 0) * 5632 : EDGE + ((size_t)(pm - 1) * 4 + 3) * 5632;
        const float* e_p2 = rr ? EDGE + ((size_t)(pm - 1) * 4 + 3) * 5632 : EDGE + ((size_t)(pm - 1) * 4 + 2) * 5632;
        const float yg = cb[ch] + cw[ch] * e_p2[tcg] + cw[5632 + ch] * e_p1[tcg] + cw[2 * 5632 + ch] * e_cur[tcg];
        const float yv = cb[DFF + ch] + cw[DFF + ch] * e_p2[tcv] + cw[5632 + DFF + ch] * e_p1[tcv] + cw[2 * 5632 + DFF + ch] * e_cur[tcv];
        G[(size_t)(pm * 256 + rr) * DFF + ch] = (bf16)f2bf(pg8::silu_f(yg) * yv);
    }
}

__device__ __forceinline__ void ffn_fixup_tile(const Args& a, int pm, int tid) {
    if ((pm & 15) == 0) return;
    const float* EDGE = (const float*)(a.ws + WS_EDGE); bf16* G = (bf16*)(a.ws + WS_G); const float* cw = a.in[I_FCW]; const float* cb = a.in[I_FCB];
    for (int idx = tid; idx < 2 * DFF; idx += NTHREADS) {
        const int ch = idx % DFF; const int rr = idx / DFF;
        const int tcg = 256 * (ch >> 7) + (ch & 127), tcv = tcg + 128;
        const float* e_cur = EDGE + ((size_t)pm * 4 + rr) * 5632; const float* e_p1 = rr ? EDGE + ((size_t)pm * 4 + 0) * 5632 : EDGE + ((size_t)(pm - 1) * 4 + 3) * 5632;
        const float* e_p2 = rr ? EDGE + ((size_t)(pm - 1) * 4 + 3) * 5632 : EDGE + ((size_t)(pm - 1) * 4 + 2) * 5632;
        const float yg = cb[ch] + cw[ch] * e_p2[tcg] + cw[5632 + ch] * e_p1[tcg] + cw[2 * 5632 + ch] * e_cur[tcg];
        const float yv = cb[DFF + ch] + cw[DFF + ch] * e_p2[tcv] + cw[5632 + DFF + ch] * e_p1[tcv] + cw[2 * 5632 + DFF + ch] * e_cur[tcv];
        G[(size_t)(pm * 256 + rr) * DFF + ch] = (bf16)f2bf(pg8::silu_f(yg) * yv);
    }
}

__device__ __forceinline__ void final_norm(const Args& a, float* outp) {
    const int tid = opaque_tid(), lane = tid & 63, wave = tid >> 6;
    const int gw = blockIdx.x * NWAVES + wave, NGW = gridDim.x * NWAVES;
    const float* rowss2 = (const float*)(a.ws + WS_ROWSS2);
    f32x4 nw[4];
#pragma unroll
    for (int j = 0; j < 4; ++j) nw[j] = *(const f32x4*)(a.in[I_FINW] + 256 * j + 4 * lane);
    for (int m0 = 4 * gw; m0 < T; m0 += 4 * NGW) {
        f32x4 v[4][4]; float rs[4];
#pragma unroll
        for (int q = 0; q < 4; ++q) { rs[q] = rsqrtf(rowss2[m0 + q] * (1.0f / DM) + EPS);
#ifdef H_BF16
            const u32x2* xb = (const u32x2*)((const bf16*)(a.ws + WS_H1B) + (size_t)(m0 + q) * DM) + lane;
#pragma unroll
            for (int j = 0; j < 4; ++j) { const u32x2 t = xb[64 * j]; v[q][j] = (f32x4){__uint_as_float(t.x << 16), __uint_as_float(t.x & 0xffff0000u), __uint_as_float(t.y << 16), __uint_as_float(t.y & 0xffff0000u)}; }
#else
            const f32x4* xr = (const f32x4*)(outp + (size_t)(m0 + q) * DM) + lane;
#pragma unroll
            for (int j = 0; j < 4; ++j) v[q][j] = xr[64 * j];
#endif
        }
#pragma unroll
        for (int q = 0; q < 4; ++q) { f32x4* xr = (f32x4*)(outp + (size_t)(m0 + q) * DM) + lane;
#pragma unroll
            for (int j = 0; j < 4; ++j) xr[64 * j] = v[q][j] * rs[q] * nw[j]; }
    }
}

#define XB_TMO      128
#define XB_XCNT(j)  (256  + 64 * (j))
#define XB_XSUB(j)  (1280 + 64 * (j))
#define XB_XGEN(j)  (2304 + 64 * (j))
#define XB_TOP      3328
#define XB_TOPGEN   3392
#define XCD_BAR_WORDS 3456
#define XB_SPIN_CAP (1u << 23)

__device__ __forceinline__ unsigned xb_ld(unsigned* p)              { return __hip_atomic_load(p, __ATOMIC_RELAXED, __HIP_MEMORY_SCOPE_AGENT); }
__device__ __forceinline__ unsigned xb_add(unsigned* p, unsigned v) { return __hip_atomic_fetch_add(p, v, __ATOMIC_RELAXED, __HIP_MEMORY_SCOPE_AGENT); }
__device__ __forceinline__ unsigned xb_xcc_id() { return (unsigned)__builtin_amdgcn_s_getreg((3 << 11) | 20) & 0xFu; }
#define XB_SPIN(cond, bar) do { unsigned _sp = 0; while (cond) { __builtin_amdgcn_s_sleep(1); \
    if ((++_sp & 255u) == 0u) { if (xb_ld(&(bar)[XB_TMO])) break; if (_sp > XB_SPIN_CAP) { atomicAdd(&(bar)[XB_TMO], 1u); break; } } } } while (0)

struct XcdBarrier {
    unsigned* bar; unsigned x;
    volatile LAS unsigned* st;
};

__device__ __forceinline__ XcdBarrier xcd_barrier_post(unsigned* bar, volatile LAS unsigned* st) {
    XcdBarrier b; b.bar = bar; b.x = xb_xcc_id(); b.st = st;
    if (threadIdx.x == 0) (void)xb_add(&bar[XB_XCNT(b.x)], 1u);
    return b;
}
__device__ __forceinline__ void xcd_barrier_complete(unsigned* bar, unsigned x, unsigned& nloc, unsigned& nx) {
    const unsigned G = gridDim.x * gridDim.y * gridDim.z;
    unsigned sum, cnt, mine, sp = 0u;
    for (;;) {
        sum = 0u; cnt = 0u; mine = 0u;
#pragma unroll
        for (unsigned j = 0; j < 16; ++j) { const unsigned c = xb_ld(&bar[XB_XCNT(j)]); sum += c; cnt += (c > 0u) ? 1u : 0u; mine = (j == x) ? c : mine; }
        if (sum == G) break;
        __builtin_amdgcn_s_sleep(1);
        if ((++sp & 255u) == 0u) { if (xb_ld(&bar[XB_TMO])) break; if (sp > XB_SPIN_CAP) { atomicAdd(&bar[XB_TMO], 1u); break; } }
    }
    nloc = mine > 0u ? mine : 1u; nx = cnt > 0u ? cnt : 1u;
}

__device__ __forceinline__ void xcd_barrier(const XcdBarrier& b) {
    asm volatile("s_waitcnt vmcnt(0)" ::: "memory");
    __syncthreads();
    if (threadIdx.x == 0) {
        unsigned* bar = b.bar;
        __builtin_amdgcn_s_waitcnt(0);
        unsigned nloc = b.st[0], nx = b.st[1];
        if (nloc == 0u) { xcd_barrier_complete(bar, b.x, nloc, nx); b.st[0] = nloc; b.st[1] = nx; }
        const unsigned old = xb_add(&bar[XB_XSUB(b.x)], 1u);
        const unsigned gen = old / nloc;
        if (old + 1u == (gen + 1u) * nloc) {
            __builtin_amdgcn_fence(__ATOMIC_RELEASE, "agent");
            asm volatile("s_waitcnt vmcnt(0)" ::: "memory");
            const unsigned og = xb_add(&bar[XB_TOP], 1u);
            const unsigned tg = og / nx;
            if (og + 1u == (tg + 1u) * nx) xb_add(&bar[XB_TOPGEN], 1u);
            else XB_SPIN(xb_ld(&bar[XB_TOPGEN]) == tg, bar);
            __builtin_amdgcn_fence(__ATOMIC_ACQUIRE, "agent");
            xb_add(&bar[XB_XGEN(b.x)], 1u);
            asm volatile("s_waitcnt vmcnt(0)" ::: "memory");
        } else {
            XB_SPIN(xb_ld(&bar[XB_XGEN(b.x)]) == gen, bar);
            __builtin_amdgcn_fence(__ATOMIC_ACQUIRE, "agent");
            asm volatile("s_waitcnt vmcnt(0)" ::: "memory");
        }
    }
    __syncthreads();
}

#ifdef USE_CG_SYNC
#define GSYNC() grid.sync()
#else
#define GSYNC() xcd_barrier(xbar)
#endif
constexpr int CV_SEG = 32, CV_NSEG = T / CV_SEG, CV_NCG = DFF / 8, CV_ITEMS = CV_NSEG * CV_NCG, CV_MAXIT = 3;
__device__ __forceinline__ void ffn_conv_inplace(const Args& a, cg::grid_group& grid, const XcdBarrier& xbar) {
    const int gt = blockIdx.x * NTHREADS + opaque_tid(), NT = gridDim.x * NTHREADS;
    bf16* U = (bf16*)(a.ws + WS_U); const float* cw = a.in[I_FCW]; const float* cb = a.in[I_FCB];
    u32x4 hal[CV_MAXIT][2];
#pragma unroll
    for (int it = 0; it < CV_MAXIT; ++it) { const int item = gt + it * NT; hal[it][0] = (u32x4){0u, 0u, 0u, 0u}; hal[it][1] = hal[it][0];
        if (item < CV_ITEMS) { const int cgp = item % CV_NCG, seg = item / CV_NCG; const int t0 = seg * CV_SEG;
            if ((t0 & (SEQ - 1)) != 0) { hal[it][0] = *(const u32x4*)(U + (size_t)(t0 - 2) * 5632 + 8 * cgp); hal[it][1] = *(const u32x4*)(U + (size_t)(t0 - 1) * 5632 + 8 * cgp); } } }
    GSYNC();
#pragma unroll
    for (int it = 0; it < CV_MAXIT; ++it) { const int item = gt + it * NT;
        if (item < CV_ITEMS) { const int cgp = item % CV_NCG, seg = item / CV_NCG; const int t0 = seg * CV_SEG; const int ch = 8 * cgp;
            float wg[3][8], wv[3][8], bg[8], bv[8];
#pragma unroll
            for (int t = 0; t < 3; ++t) { const f32x4 a0 = *(const f32x4*)(cw + t * 5632 + ch), a1 = *(const f32x4*)(cw + t * 5632 + ch + 4), c0 = *(const f32x4*)(cw + t * 5632 + DFF + ch), c1 = *(const f32x4*)(cw + t * 5632 + DFF + ch + 4);
#pragma unroll
                for (int e = 0; e < 4; ++e) { wg[t][e] = a0[e]; wg[t][4 + e] = a1[e]; wv[t][e] = c0[e]; wv[t][4 + e] = c1[e]; } }
            { const f32x4 a0 = *(const f32x4*)(cb + ch), a1 = *(const f32x4*)(cb + ch + 4), c0 = *(const f32x4*)(cb + DFF + ch), c1 = *(const f32x4*)(cb + DFF + ch + 4);
#pragma unroll
              for (int e = 0; e < 4; ++e) { bg[e] = a0[e]; bg[4 + e] = a1[e]; bv[e] = c0[e]; bv[4 + e] = c1[e]; } }
            float g2[8], g1[8], v2[8], v1[8];
            unpack8(hal[it][0], g2); unpack8(hal[it][1], g1);
            { u32x4 r2 = {0u, 0u, 0u, 0u}, r1 = r2; if ((t0 & (SEQ - 1)) != 0) { r2 = *(const u32x4*)(U + (size_t)(t0 - 2) * 5632 + DFF + ch); r1 = *(const u32x4*)(U + (size_t)(t0 - 1) * 5632 + DFF + ch); } unpack8(r2, v2); unpack8(r1, v1); }
            bf16* up = U + (size_t)t0 * 5632 + ch;
            for (int r0 = 0; r0 < CV_SEG; r0 += 4) {
                u32x4 rg[4], rv[4];
#pragma unroll
                for (int i = 0; i < 4; ++i) { rg[i] = *(const u32x4*)(up + (size_t)(r0 + i) * 5632); rv[i] = *(const u32x4*)(up + (size_t)(r0 + i) * 5632 + DFF); }
#pragma unroll
                for (int i = 0; i < 4; ++i) { float gc[8], vc[8]; unpack8(rg[i], gc); unpack8(rv[i], vc);
                    float o[8];
#pragma unroll
                    for (int e = 0; e < 8; ++e) { const float yg = bg[e] + wg[0][e] * g2[e] + wg[1][e] * g1[e] + wg[2][e] * gc[e]; const float yv = bv[e] + wv[0][e] * v2[e] + wv[1][e] * v1[e] + wv[2][e] * vc[e];
                        o[e] = pg8::silu_f(yg) * yv; g2[e] = g1[e]; g1[e] = gc[e]; v2[e] = v1[e]; v1[e] = vc[e]; }
                    u32x4 ow; ow.x = pk2(o[0], o[1]); ow.y = pk2(o[2], o[3]); ow.z = pk2(o[4], o[5]); ow.w = pk2(o[6], o[7]); *(u32x4*)(up + (size_t)(r0 + i) * 5632) = ow; }
            }
        } }
}

__global__ void __launch_bounds__(NTHREADS, 2) hymba_fwd(Args args) {
    extern __shared__ __attribute__((aligned(16))) unsigned char lds[];
    cg::grid_group grid = cg::this_grid();
    unsigned char* ws = args.ws;
    const int G = gridDim.x, bx = blockIdx.x;
    const int vcu = (G % 8 == 0) ? (bx % 8) * (G / 8) + bx / 8 : bx;
    LAS unsigned char* ldsl = (LAS unsigned char*)lds;
    volatile LAS unsigned* bst = (volatile LAS unsigned*)(ldsl + LDS_BYTES - 64);
    if (threadIdx.x == 0) { bst[0] = 0u; bst[1] = 0u; }
    __syncthreads();
    XcdBarrier xbar = xcd_barrier_post((unsigned*)(ws + WS_BAR), bst);

#ifndef REP_P0
#define REP_P0 1
#endif
    for (int rep_ = 0; rep_ < REP_P0; ++rep_) phase0(args, lds);
    grid.sync();
#ifndef REP_P1
#define REP_P1 1
#endif
    for (int rep_ = 0; rep_ < REP_P1; ++rep_)
    { pg8::Gemm g{(const pg8::bf16_t*)(ws + WS_XN), (const pg8::bf16_t*)(ws + WS_WIN), T, 3584, 1024, 1024}; pg8::StaticOrder S; S.init(T, 3584, G, bx);
      pg8::EpiBf16<0> E{(pg8::bf16_t*)(ws + WS_AQ), 512, nullptr, 512, (size_t)(WS_AK - WS_AQ) / 2, 0.125f};
      pg8::gemm_phase<pg8::EpiBf16<0>, pg8::StaticOrder, true, true>(ldsl, g, S, E); }
    GSYNC();
#ifndef REP_MA
#define REP_MA 1
#endif
    for (int rep_ = 0; rep_ < REP_MA; ++rep_)
    { const int tid2a = opaque_tid(); for (int u = bx; u < 1024; u += G) mlstm_a(args, lds, u, tid2a); }
#ifndef REP_ATT
#define REP_ATT 1
#endif
    for (int rep_ = 0; rep_ < REP_ATT; ++rep_)
    { const int tid2a = opaque_tid(); const bf16* AQp = (const bf16*)(ws + WS_AQ); const bf16* AKp = (const bf16*)(ws + WS_AK); const bf16* AVp = (const bf16*)(ws + WS_AV);
      AttnRegs R; attn_load(R, AQp, AKp, AVp, bx, tid2a);
      for (int u = bx; u < 6144; u += G) {
          attn_stage(R, lds, tid2a);
          WG_SYNC();
          if (u + G < 6144) attn_load(R, AQp, AKp, AVp, u + G, tid2a);
          attn_compute(lds, (bf16*)(ws + WS_OG), (float*)(ws + WS_LSE), u, tid2a);
          WG_SYNC();
      } }
    GSYNC();
#ifndef REP_SCAN
#define REP_SCAN 1
#endif
    for (int rep_ = 0; rep_ < REP_SCAN; ++rep_) mlstm_scan(args);
    GSYNC();
#ifndef REP_MC
#define REP_MC 1
#endif
#ifndef REP_CMB
#define REP_CMB 1
#endif
    for (int rep_ = 0; rep_ < REP_MC; ++rep_)
    { const int tid2c = opaque_tid(); for (int u = bx; u < 1024; u += G) mlstm_c(args, lds, u, tid2c); }
    for (int rep_ = 0; rep_ < REP_CMB; ++rep_) attn_combine(args);
    GSYNC();
    { pg8::Gemm g{(const pg8::bf16_t*)(ws + WS_Y), (const pg8::bf16_t*)(ws + WS_WOUT), T, 1024, 1024, 1024}; pg8::StaticOrder S; S.init(T, 1024, G, bx);
      pg8::EpiOut E{args.in[I_X], args.out, (pg8::bf16_t*)(ws + WS_H1B), (float*)(ws + WS_ROWSS)};
      pg8::gemm_phase<pg8::EpiOut, pg8::StaticOrder, true, true>(ldsl, g, S, E); }
#ifdef PROBE_DUMMY
    { pg8::Gemm g{(const pg8::bf16_t*)(ws + WS_Y), (const pg8::bf16_t*)(ws + WS_WOUT), T, 1024, 1024, 1024}; pg8::StaticOrder S; S.init(T, 1024, G, bx);
      pg8::EpiOut E{args.in[I_X], (float*)(ws + WS_MQR), (pg8::bf16_t*)(ws + WS_MQ), (float*)(ws + WS_DC)};
      pg8::gemm_phase<pg8::EpiOut, pg8::StaticOrder, true, true>(ldsl, g, S, E); }
#endif
    GSYNC();
#ifdef FFN_UNFUSED
#ifdef PROBE_CONV
    ffn_conv_inplace(args, grid, xbar);
    GSYNC();
#endif
#ifndef REP_P4
#define REP_P4 1
#endif
    for (int rep_ = 0; rep_ < REP_P4; ++rep_)
    { pg8::Gemm g{(const pg8::bf16_t*)(ws + WS_H1B), (const pg8::bf16_t*)(ws + WS_WUP), T, 2 * DFF, 1024, 1024}; pg8::StaticOrder S; S.init(T, 2 * DFF, G, bx);
      pg8::EpiUpRaw E{(pg8::bf16_t*)(ws + WS_U), (const float*)(ws + WS_ROWSS)};
      pg8::gemm_phase<pg8::EpiUpRaw, pg8::StaticOrder, true, true>(ldsl, g, S, E); }
    GSYNC();
    ffn_conv_inplace(args, grid, xbar);
    GSYNC();
#else
    { pg8::Gemm g{(const pg8::bf16_t*)(ws + WS_H1B), (const pg8::bf16_t*)(ws + WS_WUP), T, 2 * DFF, 1024, 1024}; pg8::StaticOrder S; S.init(T, 2 * DFF, G, bx);
#if defined(NOHACK2) || defined(FUSED_OLD)
      pg8::EpiUp E{(pg8::bf16_t*)(ws + WS_G), (float*)(ws + WS_EDGE), (const float*)(ws + WS_ROWSS), args.in[I_FCW], args.in[I_FCB], (LAS float*)(ldsl + LDS_AUX)};
      pg8::gemm_phase<pg8::EpiUp, pg8::StaticOrder, true, true>(ldsl, g, S, E); }
#else
      pg8::EpiUp2 E{(pg8::bf16_t*)(ws + WS_G), (float*)(ws + WS_EDGE), (const float*)(ws + WS_ROWSS), args.in[I_FCW], args.in[I_FCB], (LAS float*)(ldsl + LDS_AUX)};
      pg8::gemm_phase<pg8::EpiUp2, pg8::StaticOrder, true, true>(ldsl, g, S, E); }
#endif
    GSYNC();
#if !defined(FIXUP_LOCAL) && !defined(DBG_NOHALO)
    ffn_fixup(args);
    GSYNC();
#elif !defined(DBG_NOHALO)
    { pg8::StaticOrder S; S.init(T, 1024, G, bx); pg8::Unit uu; int last = -1; const int tidf = opaque_tid();
      for (int i = 0; S.next(i, uu); ++i) { if (uu.pm != last) ffn_fixup_tile(args, uu.pm, tidf); last = uu.pm; }
      __threadfence(); __syncthreads(); }
#endif
#endif
    { pg8::Gemm g{(const pg8::bf16_t*)(ws + FFN_A), (const pg8::bf16_t*)(ws + WS_WDOWN), T, 1024, DFF, FFN_LDA}; pg8::StaticOrder S; S.init(T, 1024, G, bx);
      pg8::EpiDown E{args.out, (float*)(ws + WS_ROWSS2), (pg8::bf16_t*)(ws + WS_H1B)};
      pg8::gemm_phase<pg8::EpiDown, pg8::StaticOrder, true, true>(ldsl, g, S, E); }
#ifdef PROBE_DUMMY
    { pg8::Gemm g{(const pg8::bf16_t*)(ws + FFN_A), (const pg8::bf16_t*)(ws + WS_WDOWN), T, 1024, DFF, FFN_LDA}; pg8::StaticOrder S; S.init(T, 1024, G, bx);
      pg8::EpiDown E{(float*)(ws + 6 * MiB), (float*)(ws + WS_DC), (pg8::bf16_t*)(ws + WS_MQ)};
      pg8::gemm_phase<pg8::EpiDown, pg8::StaticOrder, true, true>(ldsl, g, S, E); }
#endif
    GSYNC();
#ifdef REP_SYNC
    for (int rep_ = 0; rep_ < REP_SYNC; ++rep_) GSYNC();
#endif
#ifdef PROBE_DUMMY
    final_norm(args, (float*)(ws + WS_MQR));
#endif
    final_norm(args, args.out);
}

extern "C" void kernel_launch(void* const* d_in, const int* in_sizes, int n_in, void* d_out, int out_size, void* d_ws, size_t ws_size, hipStream_t stream) {
    static int grid = 0;
    if (grid == 0) {
        if (n_in != 16 || in_sizes[0] != T * DM || out_size != T * DM || ws_size < WS_END) { fprintf(stderr, "kernel_launch: unexpected shapes (n_in %d, in0 %d, out %d, ws %zu); nothing launched\n", n_in, n_in > 0 ? in_sizes[0] : -1, out_size, ws_size); grid = -1; return; }
        int dev = 0, cus = 0, per_cu = 0;
        if (hipGetDevice(&dev) != hipSuccess || hipDeviceGetAttribute(&cus, hipDeviceAttributeMultiprocessorCount, dev) != hipSuccess) { grid = -1; return; }
        if (hipFuncSetAttribute((const void*)hymba_fwd, hipFuncAttributeMaxDynamicSharedMemorySize, LDS_BYTES) != hipSuccess) { fprintf(stderr, "kernel_launch: hipFuncSetAttribute failed\n"); grid = -1; return; }
        if (hipOccupancyMaxActiveBlocksPerMultiprocessor(&per_cu, (const void*)hymba_fwd, NTHREADS, LDS_BYTES) != hipSuccess || per_cu < 1) { fprintf(stderr, "kernel_launch: occupancy query says %d\n", per_cu); per_cu = 1; }
        (void)hipGetLastError();
        grid = cus * 1;
    }
    if (grid < 0) return;
    if (hipMemsetAsync((char*)d_ws + WS_BAR, 0, XCD_BAR_WORDS * 4, stream) != hipSuccess) { fprintf(stderr, "kernel_launch: memset failed\n"); return; }
    Args a{};
    for (int i = 0; i < 16; ++i) a.in[i] = (const float*)d_in[i];
    a.out = (float*)d_out; a.ws = (unsigned char*)d_ws;
    void* kargs[] = {&a};
    const hipError_t e = hipLaunchCooperativeKernel((const void*)hymba_fwd, dim3(grid), dim3(NTHREADS), kargs, LDS_BYTES, stream);
    if (e != hipSuccess) fprintf(stderr, "kernel_launch: cooperative launch failed: %s (grid %d)\n", hipGetErrorString(e), grid);
}
```

```cpp
#define H_BF16 1
#define NOHACK2 1
#define ATT2 1
#include <hip/hip_runtime.h>
#include <hip/hip_cooperative_groups.h>
#include <cstdio>
#include <cstdint>
namespace cg = cooperative_groups;
namespace pg8 {
#define PG8_LAS __attribute__((address_space(3)))
typedef unsigned short bf16_t;
typedef short bf16x8 __attribute__((ext_vector_type(8)));
typedef float f32x4 __attribute__((ext_vector_type(4)));
typedef unsigned u32x4 __attribute__((ext_vector_type(4)));
constexpr int BM = 256, BK = 64, HALF = 128, HTB = HALF * BK * 2  , STAGE_BYTES = 8 * HTB, NXCD = 8, WGM = 8;

__host__ __device__ __forceinline__ int lds_byte(int r, int c) { const int st = (r >> 4) * 2 + (c >> 5), rr = r & 15, cc = c & 31, ob = rr * 64 + cc * 2; return st * 1024 + (ob ^ (((ob >> 9) & 1) << 5)); }
__host__ __device__ __forceinline__ void stage_rc(int b, int& R, int& C) { const int st = b / 1024, sb = b % 1024, swz = sb ^ (((sb >> 9) & 1) << 5); R = (st >> 1) * 16 + swz / 64; C = (st & 1) * 32 + (swz % 64) / 2; }
__host__ __device__ __forceinline__ int perm32(int rho) { const int n = rho >> 4, i = rho & 15; return 8 * (i >> 2) + 4 * n + (i & 3); }

struct Unit { int pm, pn; };
struct Gemm { const bf16_t* A; const bf16_t* Bt; int M, N, K, lda; };

struct StaticOrder {
    int nM, nN, nwg, G, c;
    __host__ __device__ void init(int M, int N, int G_, int c_) { nM = M / BM; nN = N / BM; nwg = nM * nN; G = G_; c = c_; }
    __host__ __device__ bool next(int i, Unit& u) const {
        const long L = (long)i * G + c; if (L >= nwg) return false;
        int wgid = (int)L; { const int q = nwg / NXCD, r = nwg % NXCD, xcd = wgid % NXCD, off = wgid / NXCD; wgid = (xcd < r ? xcd * (q + 1) : r * (q + 1) + (xcd - r) * q) + off; }
        const int nig = WGM * nN, gid = wgid / nig, fm = gid * WGM, gsz = (nM - fm) < WGM ? (nM - fm) : WGM;
        u.pm = fm + ((wgid % nig) % gsz); u.pn = (wgid % nig) / gsz; return true;
    }
    __device__ __forceinline__ void a_ready(const Unit&) const {}
    __device__ __forceinline__ void done(const Unit&) const {}
};

__device__ __forceinline__ unsigned cvt_pk_bf16(float lo, float hi) { unsigned r; asm volatile("v_cvt_pk_bf16_f32 %0, %1, %2" : "=v"(r) : "v"(lo), "v"(hi)); return r; }
typedef float f32x2 __attribute__((ext_vector_type(2)));
__device__ __forceinline__ f32x2 gelu_pk(f32x2 v) {
    const f32x2 av = __builtin_elementwise_abs(v), d = av * 0.2316418882f + 1.0f;
    f32x2 t; t.x = __builtin_amdgcn_rcpf(d.x); t.y = __builtin_amdgcn_rcpf(d.y);
    f32x2 q = t * 0.5307027145f + (-0.7265760135f); q = q * t + 0.7107068705f; q = q * t + (-0.142248368f); q = q * t + 0.127414796f; q = q * t;
    const f32x2 s = (v * v) * (-0.72134752044f);
    f32x2 e; e.x = __builtin_amdgcn_exp2f(s.x); e.y = __builtin_amdgcn_exp2f(s.y);
    const f32x2 m = v * (q * e), r = v - m;
    f32x2 o; o.x = v.x < 0.f ? m.x : r.x; o.y = v.y < 0.f ? m.y : r.y; return o;
}

template <int ACT  > struct EpiBf16 {
    static constexpr bool PERM = true, AFTER_DRAIN = false; static_assert(ACT == 0 || ACT == 1, "EpiBf16: ACT is 0 (none) or 1 (gelu_pk)");
    bf16_t* O; int ldc; const float* bias; int split_cols; size_t split_stride; float scale0;
    __device__ __forceinline__ void operator()(const f32x4 (&acc)[2][2][4][2], const Unit& u, int wr, int wc, int fr, int fq) const {
        const int row0 = u.pm * BM + wr * 64 + fr; int colt = u.pn * BM; bf16_t* base = O;
        float sc = 1.f; if (split_cols) { const int t = colt / split_cols; base += (size_t)t * split_stride; colt -= t * split_cols; if (t == 0) sc = scale0; }
        const int col0 = colt + wc * 32 + 8 * fq, bcol0 = u.pn * BM + wc * 32 + 8 * fq;
        f32x4 bv[2][2];
#pragma unroll
        for (int bj = 0; bj < 2; ++bj)
#pragma unroll
            for (int n = 0; n < 2; ++n) bv[bj][n] = bias ? *(const f32x4*)(bias + bcol0 + bj * HALF + 4 * n) : (f32x4){0.f, 0.f, 0.f, 0.f};
#pragma unroll
        for (int ai = 0; ai < 2; ++ai)
#pragma unroll
            for (int m = 0; m < 4; ++m) { bf16_t* rowp = base + (size_t)(row0 + ai * HALF + m * 16) * ldc + col0;
#pragma unroll
                for (int bj = 0; bj < 2; ++bj) { f32x4 v0 = acc[ai][bj][m][0] + bv[bj][0], v1 = acc[ai][bj][m][1] + bv[bj][1];
                    if (ACT == 1) { f32x2 a = gelu_pk((f32x2){v0[0], v0[1]}), b = gelu_pk((f32x2){v0[2], v0[3]}), c = gelu_pk((f32x2){v1[0], v1[1]}), d = gelu_pk((f32x2){v1[2], v1[3]});
                        v0 = (f32x4){a.x, a.y, b.x, b.y}; v1 = (f32x4){c.x, c.y, d.x, d.y}; }
                    v0 = v0 * sc; v1 = v1 * sc; u32x4 w; w.x = cvt_pk_bf16(v0[0], v0[1]); w.y = cvt_pk_bf16(v0[2], v0[3]); w.z = cvt_pk_bf16(v1[0], v1[1]); w.w = cvt_pk_bf16(v1[2], v1[3]);
                    *(u32x4*)(rowp + bj * HALF) = w; } }
    }
};

template <class Epi, class Sched, bool ALIGN_EPI = false, bool SP2 = false>
__device__ __forceinline__ void gemm_phase(PG8_LAS unsigned char* lds, const Gemm g, const Sched& S, const Epi& E) {
    int tid_ = threadIdx.x; asm volatile("" : "+v"(tid_)); const int tid = tid_, wid = __builtin_amdgcn_readfirstlane(tid >> 6), lane = tid & 63, wr = wid >> 2, wc = wid & 3, fr = lane & 15, fq = lane >> 4;
    const int K = g.K, nt = K / BK;
    unsigned voffA[2], voffB[2];
#pragma unroll
    for (int i = 0; i < 2; ++i) { int R, C; stage_rc(tid * 16 + i * 8192, R, C); const int Rb = Epi::PERM ? ((R & ~31) + perm32(R & 31)) : R;
        voffA[i] = (unsigned)(R * g.lda + C) * 2u; voffB[i] = (unsigned)(Rb * K + C) * 2u; }
    const size_t kstep = (size_t)(BK * 2);
    const size_t hstep = (size_t)HALF * K * 2;
    const size_t tstep = 2 * hstep;
    const size_t hstepA = (size_t)HALF * g.lda * 2, tstepA = 2 * hstepA;
    const unsigned ldsw = (unsigned)wid * 1024u;
    const int aoff = lds_byte(wr * 64 + fr, fq * 8), boff = lds_byte(wc * 32 + fr, fq * 8);
#define PG8_SA(b, h) (((b) * 2 + (h)) * HTB)
#define PG8_SB(b, h) ((4 + (b) * 2 + (h)) * HTB)
#define PG8_STAGE(bufoff, gbase, voff) do { _Pragma("unroll") for (int _i = 0; _i < 2; ++_i) \
        __builtin_amdgcn_global_load_lds((const unsigned*)((const char*)(gbase) + (voff)[_i]), (PG8_LAS unsigned*)(lds + (bufoff) + ldsw + _i * 8192), 16, 0, 0); } while (0)
#define PG8_LDA(dst, b, h) do { _Pragma("unroll") for (int m = 0; m < 4; ++m) _Pragma("unroll") for (int k = 0; k < 2; ++k) dst[m][k] = *(const PG8_LAS bf16x8*)(lds + PG8_SA(b, h) + aoff + m * 2048 + k * 1024); } while (0)
#define PG8_LDB(dst, b, h) do { _Pragma("unroll") for (int n = 0; n < 2; ++n) _Pragma("unroll") for (int k = 0; k < 2; ++k) dst[n][k] = *(const PG8_LAS bf16x8*)(lds + PG8_SB(b, h) + boff + n * 2048 + k * 1024); } while (0)
#define PG8_MMA(ai, bj, At, Bt) do { __builtin_amdgcn_s_setprio(1); _Pragma("unroll") for (int m = 0; m < 4; ++m) _Pragma("unroll") for (int n = 0; n < 2; ++n) _Pragma("unroll") for (int k = 0; k < 2; ++k) \
        acc[ai][bj][m][n] = __builtin_amdgcn_mfma_f32_16x16x32_bf16(Bt[n][k], At[m][k], acc[ai][bj][m][n], 0, 0, 0); __builtin_amdgcn_s_setprio(0); } while (0)
#define PG8_WAIT_V(n) asm volatile("s_waitcnt vmcnt(" #n ")" ::: "memory")
#define PG8_WAIT_L(n) asm volatile("s_waitcnt lgkmcnt(" #n ")" ::: "memory")
#define PG8_BAR __builtin_amdgcn_s_barrier()
#define PG8_SCHED __builtin_amdgcn_sched_barrier(0)
    Unit cur, nxt; int ui = 0;
    if (!S.next(0, cur)) return;
    f32x4 acc[2][2][4][2];
#pragma unroll
    for (int a = 0; a < 2; ++a)
#pragma unroll
        for (int b = 0; b < 2; ++b)
#pragma unroll
            for (int m = 0; m < 4; ++m)
#pragma unroll
                for (int n = 0; n < 2; ++n) acc[a][b][m][n] = (f32x4){0.f, 0.f, 0.f, 0.f};
    bf16x8 At[4][2], B0[2][2], B1[2][2];
    const char* cA = (const char*)g.A + (size_t)cur.pm * tstepA; const char* cB = (const char*)g.Bt + (size_t)cur.pn * tstep;
    S.a_ready(cur);
    if constexpr (SP2) {
        PG8_STAGE(PG8_SB(0, 0), cB, voffB); PG8_STAGE(PG8_SB(0, 1), cB + hstep, voffB); PG8_STAGE(PG8_SA(0, 0), cA, voffA); PG8_STAGE(PG8_SA(0, 1), cA + hstepA, voffA);
        if (wr == 1) PG8_BAR;
        PG8_WAIT_V(2); PG8_BAR;
        PG8_STAGE(PG8_SB(1, 0), cB + kstep, voffB); PG8_STAGE(PG8_SA(1, 0), cA + kstep, voffA); PG8_STAGE(PG8_SB(1, 1), cB + hstep + kstep, voffB);
        PG8_WAIT_V(6); PG8_BAR;
    } else {
        PG8_STAGE(PG8_SB(0, 0), cB, voffB); PG8_STAGE(PG8_SA(0, 0), cA, voffA); PG8_STAGE(PG8_SB(0, 1), cB + hstep, voffB); PG8_STAGE(PG8_SA(0, 1), cA + hstepA, voffA);
        if (wr == 1) PG8_BAR;
        PG8_WAIT_V(4); PG8_BAR;
        PG8_STAGE(PG8_SB(1, 0), cB + kstep, voffB); PG8_STAGE(PG8_SA(1, 0), cA + kstep, voffA); PG8_STAGE(PG8_SB(1, 1), cB + hstep + kstep, voffB);
        PG8_WAIT_V(6); PG8_BAR;
    }
    for (;;) {
        const bool has_next = S.next(ui + 1, nxt);
        const char* nA = has_next ? (const char*)g.A + (size_t)nxt.pm * tstepA : cA; const char* nB = has_next ? (const char*)g.Bt + (size_t)nxt.pn * tstep : cB;
        for (int t = 0; t < nt; t += 2) {
            const bool last = (t == nt - 2);
            const char* a1 = cA + (size_t)(t + 1) * kstep;
            const char* a2 = last ? nA : cA + (size_t)(t + 2) * kstep; const char* b2 = last ? nB : cB + (size_t)(t + 2) * kstep;
            const char* a3 = a2 + kstep; const char* b3 = b2 + kstep;
            if (last && has_next) S.a_ready(nxt);
            if constexpr (SP2) {
            PG8_LDB(B0, 0, 0); PG8_LDB(B1, 0, 1); PG8_SCHED; PG8_LDA(At, 0, 0); PG8_STAGE(PG8_SA(1, 1), a1 + hstepA, voffA);
            PG8_WAIT_V(8); PG8_WAIT_L(0); PG8_BAR; PG8_MMA(0, 0, At, B0); PG8_MMA(0, 1, At, B1); PG8_BAR; PG8_SCHED;
            PG8_LDA(At, 0, 1); PG8_STAGE(PG8_SB(0, 0), b2, voffB); PG8_STAGE(PG8_SB(0, 1), b2 + hstep, voffB); PG8_STAGE(PG8_SA(0, 0), a2, voffA);
            PG8_WAIT_V(8); PG8_WAIT_L(0); PG8_BAR; PG8_MMA(1, 0, At, B0); PG8_MMA(1, 1, At, B1); PG8_BAR; PG8_SCHED;
            PG8_LDB(B0, 1, 0); PG8_LDB(B1, 1, 1); PG8_SCHED; PG8_LDA(At, 1, 0); PG8_STAGE(PG8_SA(0, 1), a2 + hstepA, voffA);
            PG8_WAIT_V(8); PG8_WAIT_L(0); PG8_BAR; PG8_MMA(0, 0, At, B0); PG8_MMA(0, 1, At, B1); PG8_BAR; PG8_SCHED;
            PG8_LDA(At, 1, 1); PG8_STAGE(PG8_SB(1, 0), b3, voffB); PG8_STAGE(PG8_SB(1, 1), b3 + hstep, voffB); PG8_STAGE(PG8_SA(1, 0), a3, voffA);
            PG8_WAIT_V(8); PG8_WAIT_L(0); PG8_BAR; PG8_MMA(1, 0, At, B0); PG8_MMA(1, 1, At, B1); PG8_BAR; PG8_SCHED;
            } else {
            PG8_LDB(B0, 0, 0); PG8_SCHED; PG8_LDA(At, 0, 0); PG8_STAGE(PG8_SA(1, 1), a1 + hstepA, voffA);
            PG8_WAIT_L(8); PG8_BAR; PG8_WAIT_L(0); PG8_MMA(0, 0, At, B0); PG8_BAR; PG8_SCHED;
            PG8_LDB(B1, 0, 1); PG8_STAGE(PG8_SB(0, 0), b2, voffB);
            PG8_BAR; PG8_WAIT_L(0); PG8_MMA(0, 1, At, B1); PG8_BAR;
            PG8_LDA(At, 0, 1); PG8_STAGE(PG8_SA(0, 0), a2, voffA);
            PG8_BAR; PG8_WAIT_L(0); PG8_MMA(1, 0, At, B0); PG8_BAR; PG8_SCHED;
            PG8_STAGE(PG8_SB(0, 1), b2 + hstep, voffB);
            PG8_WAIT_V(6); PG8_BAR; PG8_MMA(1, 1, At, B1); PG8_BAR;
            PG8_LDB(B0, 1, 0); PG8_SCHED; PG8_LDA(At, 1, 0); PG8_STAGE(PG8_SA(0, 1), a2 + hstepA, voffA);
            PG8_WAIT_L(8); PG8_BAR; PG8_WAIT_L(0); PG8_MMA(0, 0, At, B0); PG8_BAR; PG8_SCHED;
            PG8_LDB(B1, 1, 1); PG8_STAGE(PG8_SB(1, 0), b3, voffB);
            PG8_BAR; PG8_WAIT_L(0); PG8_MMA(0, 1, At, B1); PG8_BAR;
            PG8_LDA(At, 1, 1); PG8_STAGE(PG8_SA(1, 0), a3, voffA);
            PG8_BAR; PG8_WAIT_L(0); PG8_MMA(1, 0, At, B0); PG8_BAR; PG8_SCHED;
            PG8_STAGE(PG8_SB(1, 1), b3 + hstep, voffB);
            PG8_WAIT_V(6); PG8_BAR; PG8_MMA(1, 1, At, B1); PG8_BAR;
            }
        }
        if constexpr (ALIGN_EPI) { if (wr == 0) PG8_BAR; }
        if constexpr (!Epi::AFTER_DRAIN) { E(acc, cur, wr, wc, fr, fq); S.done(cur); }
        if (!has_next) break;
#pragma unroll
        for (int a = 0; a < 2; ++a)
#pragma unroll
            for (int b = 0; b < 2; ++b)
#pragma unroll
                for (int m = 0; m < 4; ++m)
#pragma unroll
                    for (int n = 0; n < 2; ++n) acc[a][b][m][n] = (f32x4){0.f, 0.f, 0.f, 0.f};
        cur = nxt; cA = nA; cB = nB; ++ui;
        if constexpr (ALIGN_EPI) { if (wr == 1) PG8_BAR; }
    }
    PG8_WAIT_V(0);
    if constexpr (!ALIGN_EPI) { if (wr == 0) PG8_BAR; }
    PG8_BAR;
    if constexpr (Epi::AFTER_DRAIN) { E.fused(acc, cur, wr, wc, fr, fq, lds, wid, lane); S.done(cur); }
#undef PG8_SA
#undef PG8_SB
#undef PG8_STAGE
#undef PG8_LDA
#undef PG8_LDB
#undef PG8_MMA
#undef PG8_WAIT_V
#undef PG8_WAIT_L
#undef PG8_BAR
#undef PG8_SCHED
}
}

namespace pg8 {
typedef unsigned u32x2 __attribute__((ext_vector_type(2)));
__device__ __forceinline__ float dpp_shr1(float old, float src) { return __builtin_bit_cast(float, __builtin_amdgcn_update_dpp(__builtin_bit_cast(int, old), __builtin_bit_cast(int, src), 0x111, 0xf, 0xf, false)); }
__device__ __forceinline__ float dpp_shr2(float old, float src) { return __builtin_bit_cast(float, __builtin_amdgcn_update_dpp(__builtin_bit_cast(int, old), __builtin_bit_cast(int, src), 0x112, 0xf, 0xf, false)); }
__device__ __forceinline__ float dpp_shl15(float src) { return __builtin_bit_cast(float, __builtin_amdgcn_update_dpp(0, __builtin_bit_cast(int, src), 0x10F, 0xf, 0xf, true)); }
__device__ __forceinline__ float dpp_shl14(float src) { return __builtin_bit_cast(float, __builtin_amdgcn_update_dpp(0, __builtin_bit_cast(int, src), 0x10E, 0xf, 0xf, true)); }
__device__ __forceinline__ float silu_f(float v) { return v * __builtin_amdgcn_rcpf(1.0f + __expf(-v)); }

struct EpiOut {
    static constexpr bool PERM = false, AFTER_DRAIN = false;
    const float* x; float* out; bf16_t* hb; float* rowss;
    __device__ __forceinline__ void operator()(const f32x4 (&acc)[2][2][4][2], const Unit& u, int wr, int wc, int fr, int fq) const {
        const int col0 = u.pn * BM + wc * 32 + 4 * fq;
#pragma unroll
        for (int ai = 0; ai < 2; ++ai)
#pragma unroll
            for (int m = 0; m < 4; ++m) {
                const int row = u.pm * BM + ai * HALF + wr * 64 + m * 16 + fr; const size_t off = (size_t)row * 1024 + col0; float ss = 0.f;
#pragma unroll
                for (int bj = 0; bj < 2; ++bj)
#pragma unroll
                    for (int n = 0; n < 2; ++n) { const size_t o = off + bj * HALF + n * 16; const f32x4 xv = *(const f32x4*)(x + o); const f32x4 h = acc[ai][bj][m][n] + xv;
#ifndef H_BF16
                        *(f32x4*)(out + o) = h;
#endif
                        ss += (h[0] * h[0] + h[1] * h[1]) + (h[2] * h[2] + h[3] * h[3]);
                        u32x2 w; w.x = cvt_pk_bf16(h[0], h[1]); w.y = cvt_pk_bf16(h[2], h[3]); *(u32x2*)(hb + o) = w; }
                ss += __shfl_xor(ss, 16); ss += __shfl_xor(ss, 32);
                if (fq == 0) atomicAdd(rowss + row, ss);
            }
    }
};
struct EpiDown {
    static constexpr bool PERM = false, AFTER_DRAIN = false;
    float* out; float* rowss2; bf16_t* hb;
    __device__ __forceinline__ void operator()(const f32x4 (&acc)[2][2][4][2], const Unit& u, int wr, int wc, int fr, int fq) const {
        const int col0 = u.pn * BM + wc * 32 + 4 * fq;
#pragma unroll
        for (int ai = 0; ai < 2; ++ai)
#pragma unroll
            for (int m = 0; m < 4; ++m) {
                const int row = u.pm * BM + ai * HALF + wr * 64 + m * 16 + fr; const size_t off = (size_t)row * 1024 + col0; float ss = 0.f;
#pragma unroll
                for (int bj = 0; bj < 2; ++bj)
#pragma unroll
                    for (int n = 0; n < 2; ++n) { const size_t o = off + bj * HALF + n * 16;
#ifdef H_BF16
                        const u32x2 xb = *(const u32x2*)(hb + o); const f32x4 xv = {__uint_as_float(xb.x << 16), __uint_as_float(xb.x & 0xffff0000u), __uint_as_float(xb.y << 16), __uint_as_float(xb.y & 0xffff0000u)};
#else
                        const f32x4 xv = *(const f32x4*)(out + o);
#endif
#ifdef DBG_ZERO_FFN
                        const f32x4 h = xv;
#else
                        const f32x4 h = acc[ai][bj][m][n] + xv;
#endif

#ifdef H_BF16
                        { u32x2 w; w.x = cvt_pk_bf16(h[0], h[1]); w.y = cvt_pk_bf16(h[2], h[3]); *(u32x2*)(hb + o) = w; }
#else
                        *(f32x4*)(out + o) = h;
#endif
                        ss += (h[0] * h[0] + h[1] * h[1]) + (h[2] * h[2] + h[3] * h[3]); }
                ss += __shfl_xor(ss, 16); ss += __shfl_xor(ss, 32);
                if (fq == 0) atomicAdd(rowss2 + row, ss);
            }
    }
};
struct EpiUp {
    static constexpr bool PERM = true, AFTER_DRAIN = false;
    bf16_t* G; float* EDGE; const float* rowss; const float* cw; const float* cb; PG8_LAS float* halo;
    __device__ __forceinline__ void operator()(f32x4 (&acc)[2][2][4][2], const Unit& u, int wr, int wc, int fr, int fq) const {
#pragma unroll
        for (int ai = 0; ai < 2; ++ai)
#pragma unroll
            for (int m = 0; m < 4; ++m) { const int row = u.pm * BM + ai * HALF + wr * 64 + m * 16 + fr; float rs = rsqrtf(rowss[row] * (1.0f / 1024.0f) + 1e-6f);
#ifdef DBG_RS1
                rs = 1.0f;
#endif
#pragma unroll
                for (int bj = 0; bj < 2; ++bj)
#pragma unroll
                    for (int n = 0; n < 2; ++n) acc[ai][bj][m][n] = acc[ai][bj][m][n] * rs; }
        const int tc0 = wc * 32 + 8 * fq;
        if (fr >= 14) {
#pragma unroll
            for (int ai = 0; ai < 2; ++ai)
#pragma unroll
                for (int bj = 0; bj < 2; ++bj)
#pragma unroll
                    for (int n = 0; n < 2; ++n) *(PG8_LAS f32x4*)(halo + ((ai * 2 + wr) * 2 + (fr - 14)) * 256 + bj * HALF + tc0 + 4 * n) = acc[ai][bj][3][n];
#ifndef DBG_NOHALO
            if (wr == 1) {
#pragma unroll
                for (int bj = 0; bj < 2; ++bj)
#pragma unroll
                    for (int n = 0; n < 2; ++n) *(f32x4*)(EDGE + ((size_t)u.pm * 4 + 2 + (fr - 14)) * 5632 + u.pn * BM + bj * HALF + tc0 + 4 * n) = acc[1][bj][3][n];
            }
#endif
        }
#ifndef DBG_NOHALO
        if (fr < 2 && wr == 0) {
#pragma unroll
            for (int bj = 0; bj < 2; ++bj)
#pragma unroll
                for (int n = 0; n < 2; ++n) *(f32x4*)(EDGE + ((size_t)u.pm * 4 + fr) * 5632 + u.pn * BM + bj * HALF + tc0 + 4 * n) = acc[0][bj][0][n];
        }
#endif
        asm volatile("s_waitcnt lgkmcnt(0)" ::: "memory"); __builtin_amdgcn_s_barrier(); asm volatile("" ::: "memory");
        const bool first_of_seq = (u.pm & 15) == 0;
        const int ch0 = u.pn * HALF + tc0;
#pragma unroll
        for (int n = 0; n < 2; ++n) {
            f32x4 wg[3], wv[3], bg, bv;
#pragma unroll
            for (int t = 0; t < 3; ++t) { wg[t] = *(const f32x4*)(cw + t * 5632 + ch0 + 4 * n); wv[t] = *(const f32x4*)(cw + t * 5632 + 2816 + ch0 + 4 * n); }
            bg = *(const f32x4*)(cb + ch0 + 4 * n); bv = *(const f32x4*)(cb + 2816 + ch0 + 4 * n);
#pragma unroll
            for (int ai = 0; ai < 2; ++ai) {
                bf16_t* gp = G + (size_t)(u.pm * BM + ai * HALF + wr * 64 + 48 + fr) * 2816 + ch0 + 4 * n; asm volatile("" : "+v"(gp));
#pragma unroll
                for (int m = 3; m >= 0; --m) {
                    const f32x4 cg_ = acc[ai][0][m][n], cv_ = acc[ai][1][m][n];
                    f32x4 og1, og2, ov1, ov2;
                    if (m > 0) {
#pragma unroll
                        for (int j = 0; j < 4; ++j) { og1[j] = dpp_shl15(acc[ai][0][m - 1][n][j]); og2[j] = dpp_shl14(acc[ai][0][m - 1][n][j]); ov1[j] = dpp_shl15(acc[ai][1][m - 1][n][j]); ov2[j] = dpp_shl14(acc[ai][1][m - 1][n][j]); }
                    } else {
                        f32x4 hg1 = {0.f, 0.f, 0.f, 0.f}, hg2 = hg1, hv1 = hg1, hv2 = hg1;
#ifdef DBG_NOHALO
                        if (false) {
#else
                        if (fr < 2 && (ai + wr) > 0) {
#endif
                            const int pg = (wr == 1) ? (ai * 2) : 1;
                            PG8_LAS const float* hp = halo + pg * 2 * 256 + tc0 + 4 * n;
                            hg1 = *(PG8_LAS const f32x4*)(hp + 256); hv1 = *(PG8_LAS const f32x4*)(hp + 256 + HALF);
                            hg2 = *(PG8_LAS const f32x4*)(hp + fr * 256); hv2 = *(PG8_LAS const f32x4*)(hp + fr * 256 + HALF);
                        }
                        og1 = hg1; og2 = hg2; ov1 = hv1; ov2 = hv2; }
                    float r[4];
#pragma unroll
                    for (int j = 0; j < 4; ++j) {
#ifdef DBG_SHFL
                        const int l_ = fq * 16 + fr;
                        float g1 = __shfl(cg_[j], (l_ - 1) & 63), g2 = __shfl(cg_[j], (l_ - 2) & 63), v1 = __shfl(cv_[j], (l_ - 1) & 63), v2 = __shfl(cv_[j], (l_ - 2) & 63);
                        float pg1 = hg1[j], pg2 = hg2[j], pv1 = hv1[j], pv2 = hv2[j];
                        if (m > 0) { const float a_ = acc[ai][0][m > 0 ? m - 1 : 0][n][j], b_ = acc[ai][1][m > 0 ? m - 1 : 0][n][j];
                            pg1 = __shfl(a_, (l_ + 15) & 63); pg2 = __shfl(a_, (l_ + 14) & 63); pv1 = __shfl(b_, (l_ + 15) & 63); pv2 = __shfl(b_, (l_ + 14) & 63); }
                        if (fr < 1) { g1 = pg1; v1 = pv1; }
                        if (fr < 2) { g2 = pg2; v2 = pv2; }
#else
                        const float g1 = dpp_shr1(og1[j], cg_[j]), g2 = dpp_shr2(og2[j], cg_[j]);
                        const float v1 = dpp_shr1(ov1[j], cv_[j]), v2 = dpp_shr2(ov2[j], cv_[j]);
#endif
#ifdef DBG_NOPREV
                        const float yg = bg[j] + wg[2][j] * cg_[j]; const float yv = bv[j] + wv[2][j] * cv_[j]; (void)g1; (void)g2; (void)v1; (void)v2;
#else
#ifdef DBG_DROP
                        const float yg = bg[j] + ((DBG_DROP & 1) ? 0.f : wg[0][j] * g2) + ((DBG_DROP & 2) ? 0.f : wg[1][j] * g1) + wg[2][j] * cg_[j];
                        const float yv = bv[j] + ((DBG_DROP & 4) ? 0.f : wv[0][j] * v2) + ((DBG_DROP & 8) ? 0.f : wv[1][j] * v1) + wv[2][j] * cv_[j];
#else
                        const float yg = bg[j] + wg[0][j] * g2 + wg[1][j] * g1 + wg[2][j] * cg_[j];
                        const float yv = bv[j] + wv[0][j] * v2 + wv[1][j] * v1 + wv[2][j] * cv_[j];
#endif
#endif
                        r[j] = silu_f(yg) * yv;
#ifdef DBG_LINEAR
                        r[j] = cg_[j] + 0.5f * cv_[j];
#endif
#ifdef DBG_SILU_RAW
                        r[j] = silu_f(cg_[j]) * cv_[j];
#endif
#ifdef DBG_TAPS
                        r[j] = g1 + 0.5f * v1 + 0.25f * g2 + 0.125f * v2;
#endif
#ifdef DBG_WTS
                        r[j] = wg[0][j] + 2.f * wg[1][j] + 3.f * wv[0][j] + 4.f * wv[1][j];
#endif
#ifdef DBG_LINCONV
                        r[j] = yg + 0.5f * yv;
#endif
                    }
                    const unsigned p0 = cvt_pk_bf16(r[0], r[1]), p1 = cvt_pk_bf16(r[2], r[3]);
#ifdef NOHACK2
                    { const bool deferred = (ai == 0 && wr == 0 && m == 0 && fr < 2 && !first_of_seq);
                      if (!deferred) { u32x2 w2; w2.x = p0; w2.y = p1; *(u32x2*)gp = w2; }
                      gp -= 16 * 2816; asm volatile("" : "+v"(gp)); }
                    if (false) {
#elif defined(DBG_NOHACK)
                    { const int row = u.pm * BM + ai * HALF + wr * 64 + m * 16 + fr;
                      const bool deferred = (ai == 0 && wr == 0 && m == 0 && fr < 2 && !first_of_seq);
                      if (!deferred) { u32x2 w2; w2.x = p0; w2.y = p1; *(u32x2*)(G + (size_t)row * 2816 + ch0 + 4 * n) = w2; } }
                    if (false) {
#else
                    if (n == 0) { acc[ai][0][m][0][0] = __builtin_bit_cast(float, p0); acc[ai][0][m][0][1] = __builtin_bit_cast(float, p1); }
                    else {
#endif
                        const int row = u.pm * BM + ai * HALF + wr * 64 + m * 16 + fr;
#ifdef DBG_NOHALO
                        const bool deferred = false; (void)first_of_seq;
#else
                        const bool deferred = (ai == 0 && wr == 0 && m == 0 && fr < 2 && !first_of_seq);
#endif
                        if (!deferred) { u32x4 w; w.x = __builtin_bit_cast(unsigned, acc[ai][0][m][0][0]); w.y = __builtin_bit_cast(unsigned, acc[ai][0][m][0][1]); w.z = p0; w.w = p1;
                            *(u32x4*)(G + (size_t)row * 2816 + ch0) = w; }
                    }
                }
            }
        }
    }
};
struct EpiUpRaw {
    static constexpr bool PERM = true, AFTER_DRAIN = false;
    bf16_t* U; const float* rowss;
    __device__ __forceinline__ void operator()(const f32x4 (&acc)[2][2][4][2], const Unit& u, int wr, int wc, int fr, int fq) const {
        const int ch0 = u.pn * HALF + wc * 32 + 8 * fq;
#pragma unroll
        for (int ai = 0; ai < 2; ++ai)
#pragma unroll
            for (int m = 0; m < 4; ++m) { const int row = u.pm * BM + ai * HALF + wr * 64 + m * 16 + fr; const float rs = rsqrtf(rowss[row] * (1.0f / 1024.0f) + 1e-6f);
#pragma unroll
                for (int bj = 0; bj < 2; ++bj) { const f32x4 v0 = acc[ai][bj][m][0] * rs, v1 = acc[ai][bj][m][1] * rs;
                    u32x4 w; w.x = cvt_pk_bf16(v0[0], v0[1]); w.y = cvt_pk_bf16(v0[2], v0[3]); w.z = cvt_pk_bf16(v1[0], v1[1]); w.w = cvt_pk_bf16(v1[2], v1[3]);
                    *(u32x4*)(U + (size_t)row * 5632 + bj * 2816 + ch0) = w; } }
    }
};
struct EpiUp2 {
    static constexpr bool PERM = true, AFTER_DRAIN = false;
    bf16_t* G; float* EDGE; const float* rowss; const float* cw; const float* cb; PG8_LAS float* halo;
    __device__ __forceinline__ void operator()(f32x4 (&acc)[2][2][4][2], const Unit& u, int wr, int wc, int fr_in, int fq_in) const {
        int fr = fr_in, fq = fq_in; asm volatile("" : "+v"(fr), "+v"(fq));
#pragma unroll
        for (int ai = 0; ai < 2; ++ai)
#pragma unroll
            for (int m = 0; m < 4; ++m) { const float rs_ = rsqrtf(rowss[u.pm * BM + ai * HALF + wr * 64 + m * 16 + fr] * (1.0f / 1024.0f) + 1e-6f);
#pragma unroll
                for (int bj = 0; bj < 2; ++bj)
#pragma unroll
                    for (int n = 0; n < 2; ++n) acc[ai][bj][m][n] = acc[ai][bj][m][n] * rs_; }
        const int tc0 = wc * 32 + 8 * fq;
        if (fr >= 14) {
#pragma unroll
            for (int ai = 0; ai < 2; ++ai)
#pragma unroll
                for (int bj = 0; bj < 2; ++bj)
#pragma unroll
                    for (int n = 0; n < 2; ++n) { const f32x4 v = acc[ai][bj][3][n];
                        *(PG8_LAS f32x4*)(halo + ((ai * 2 + wr) * 2 + (fr - 14)) * 256 + bj * HALF + tc0 + 4 * n) = v;
                        if (ai == 1 && wr == 1) *(f32x4*)(EDGE + ((size_t)u.pm * 4 + 2 + (fr - 14)) * 5632 + u.pn * BM + bj * HALF + tc0 + 4 * n) = v; }
        }
        if (fr < 2 && wr == 0) {
#pragma unroll
            for (int bj = 0; bj < 2; ++bj)
#pragma unroll
                for (int n = 0; n < 2; ++n) *(f32x4*)(EDGE + ((size_t)u.pm * 4 + fr) * 5632 + u.pn * BM + bj * HALF + tc0 + 4 * n) = acc[0][bj][0][n];
        }
        asm volatile("s_waitcnt lgkmcnt(0)" ::: "memory"); __builtin_amdgcn_s_barrier(); asm volatile("" ::: "memory");
        const bool first_of_seq = (u.pm & 15) == 0;
        const int ch0 = u.pn * HALF + tc0;
#pragma unroll
        for (int n = 0; n < 2; ++n) {
            asm volatile("" ::: "memory");
            { f32x4 w0 = *(const f32x4*)(cw + ch0 + 4 * n), w1 = *(const f32x4*)(cw + 5632 + ch0 + 4 * n), w2 = *(const f32x4*)(cw + 2 * 5632 + ch0 + 4 * n), bb = *(const f32x4*)(cb + ch0 + 4 * n);
#pragma unroll
              for (int ai = 0; ai < 2; ++ai) {
                f32x4 o1 = {0.f, 0.f, 0.f, 0.f}, o2 = o1;
                if (fr < 2 && (ai + wr) > 0) { const int pgi = (wr == 1) ? (ai * 2) : 1; PG8_LAS const float* hp = halo + pgi * 2 * 256 + tc0 + 4 * n;
                    o1 = *(PG8_LAS const f32x4*)(hp + 256); o2 = *(PG8_LAS const f32x4*)(hp + fr * 256); }
#pragma unroll
                for (int m = 0; m < 4; ++m) { const f32x4 c_ = acc[ai][0][m][n]; f32x4 s_;
#pragma unroll
                    for (int j = 0; j < 4; ++j) { const float p1 = dpp_shr1(o1[j], c_[j]), p2 = dpp_shr2(o2[j], c_[j]);
                        s_[j] = silu_f(bb[j] + w0[j] * p2 + w1[j] * p1 + w2[j] * c_[j]); o1[j] = dpp_shl15(c_[j]); o2[j] = dpp_shl14(c_[j]); }
                    acc[ai][0][m][n] = s_; __builtin_amdgcn_sched_barrier(0); } } }
            asm volatile("" ::: "memory");
            { f32x4 w0 = *(const f32x4*)(cw + 2816 + ch0 + 4 * n), w1 = *(const f32x4*)(cw + 5632 + 2816 + ch0 + 4 * n), w2 = *(const f32x4*)(cw + 2 * 5632 + 2816 + ch0 + 4 * n), bb = *(const f32x4*)(cb + 2816 + ch0 + 4 * n);
#pragma unroll
              for (int ai = 0; ai < 2; ++ai) {
                f32x4 o1 = {0.f, 0.f, 0.f, 0.f}, o2 = o1;
                if (fr < 2 && (ai + wr) > 0) { const int pgi = (wr == 1) ? (ai * 2) : 1; PG8_LAS const float* hp = halo + pgi * 2 * 256 + HALF + tc0 + 4 * n;
                    o1 = *(PG8_LAS const f32x4*)(hp + 256); o2 = *(PG8_LAS const f32x4*)(hp + fr * 256); }
                bf16_t* gp = G + (size_t)(u.pm * BM + ai * HALF + wr * 64 + fr) * 2816 + ch0 + 4 * n; asm volatile("" : "+v"(gp));
#pragma unroll
                for (int m = 0; m < 4; ++m) { const f32x4 c_ = acc[ai][1][m][n]; const f32x4 sg = acc[ai][0][m][n]; float r[4];
#pragma unroll
                    for (int j = 0; j < 4; ++j) { const float p1 = dpp_shr1(o1[j], c_[j]), p2 = dpp_shr2(o2[j], c_[j]);
                        r[j] = sg[j] * (bb[j] + w0[j] * p2 + w1[j] * p1 + w2[j] * c_[j]); o1[j] = dpp_shl15(c_[j]); o2[j] = dpp_shl14(c_[j]); }
                    const bool deferred = (ai == 0 && wr == 0 && m == 0 && fr < 2 && !first_of_seq);
                    if (!deferred) { u32x2 w; w.x = cvt_pk_bf16(r[0], r[1]); w.y = cvt_pk_bf16(r[2], r[3]); *(u32x2*)gp = w; }
                    gp += 16 * 2816; asm volatile("" : "+v"(gp)); __builtin_amdgcn_sched_barrier(0); } } }
        }
    }
};
}


#define LAS __attribute__((address_space(3)))
typedef unsigned short bf16;
typedef float f32x4 __attribute__((ext_vector_type(4)));
typedef float f32x16 __attribute__((ext_vector_type(16)));
typedef short bf16x8 __attribute__((ext_vector_type(8)));
typedef short s16x4 __attribute__((ext_vector_type(4)));
typedef unsigned u32x4 __attribute__((ext_vector_type(4)));
typedef unsigned u32x2 __attribute__((ext_vector_type(2)));

constexpr int T = 32768, DM = 1024, SEQ = 4096, NBATCH = 8, PROJW = 3592, DFF = 2816;
constexpr int NWAVES = 8, NTHREADS = 512;
constexpr float EPS = 1e-6f;
constexpr size_t MiB = 1u << 20, KiB = 1u << 10;
constexpr size_t WS_ROWSS = 0, WS_ROWSS2 = 128 * KiB, WS_GATES = 256 * KiB  , WS_CHS = 1280 * KiB  , WS_MC = 1288 * KiB  ,
                 WS_DN = 1536 * KiB  , WS_NH = 2 * MiB  , WS_LSE = 3 * MiB  ;
constexpr size_t WS_BAR = 1408 * KiB  ;
constexpr size_t WS_WIN = 6 * MiB, WS_WOUT = 13 * MiB, WS_WUP = 15 * MiB, WS_WDOWN = 26 * MiB;
constexpr size_t WS_XN = 32 * MiB, WS_OG = 32 * MiB  , WS_H1B = 32 * MiB;
constexpr size_t WS_Y = 128 * MiB;
constexpr size_t WS_AQ = 192 * MiB, WS_AK = 224 * MiB, WS_AV = 256 * MiB, WS_MQR = 288 * MiB, WS_MKR = 320 * MiB, WS_MV = 352 * MiB, WS_MO = 384 * MiB;
constexpr size_t WS_CH = 288 * MiB  ;
constexpr size_t WS_MQ = 416 * MiB, WS_MK = 448 * MiB, WS_DC = 480 * MiB  ;
constexpr size_t WS_G = 192 * MiB  , WS_EDGE = 368 * MiB  ;
constexpr size_t WS_U = 96 * MiB  ;
constexpr size_t WS_END = 512 * MiB;
static_assert(WS_G + (size_t)T * DFF * 2 <= WS_EDGE && WS_EDGE + (size_t)128 * 4 * 5632 * 4 <= WS_MQ, "ws map");
#ifdef FFN_UNFUSED
constexpr size_t FFN_A = WS_U; constexpr int FFN_LDA = 5632;
#else
constexpr size_t FFN_A = WS_G; constexpr int FFN_LDA = DFF;
#endif
constexpr int LDS_BYTES = 147456;
constexpr int LDS_AUX = 131072;

__device__ __forceinline__ float bf2f(unsigned short v) { return __uint_as_float(((unsigned)v) << 16); }
__device__ __forceinline__ unsigned f2bf(float f) { unsigned u = __float_as_uint(f); return (u + 0x7fffu + ((u >> 16) & 1u)) >> 16; }
__device__ __forceinline__ unsigned pk2(float lo, float hi) { return f2bf(lo) | (f2bf(hi) << 16); }
__device__ __forceinline__ float wave_sum(float v) {
#pragma unroll
    for (int o = 1; o < 64; o <<= 1) v += __shfl_xor(v, o);
    return v;
}
__device__ __forceinline__ float wave_max(float v) {
#pragma unroll
    for (int o = 1; o < 64; o <<= 1) v = fmaxf(v, __shfl_xor(v, o));
    return v;
}
#define WG_SYNC() __syncthreads()
__device__ __forceinline__ int opaque_tid() { int t = threadIdx.x; asm volatile("" : "+v"(t)); return t; }

struct Args { const float* in[16]; float* out; unsigned char* ws; };
enum { I_X = 0, I_WIN, I_MCW, I_MCB, I_IB, I_FB, I_ANW, I_MNW, I_WOUT, I_MIXNW, I_FFNNW, I_WUP, I_FCW, I_FCB, I_WDOWN, I_FINW };

__device__ __forceinline__ void transpose_item(const float* W, int ldw, int K, bf16* WT, int dst_row0, int k0, int n0, const float* kscale, float* scr, int lane) {
#pragma unroll 8
    for (int i = 0; i < 32; ++i) { const int kk = 2 * i + (lane >> 5); float v = W[(size_t)(k0 + kk) * ldw + n0 + (lane & 31)]; if (kscale) v *= kscale[k0 + kk]; scr[kk * 33 + (lane & 31)] = v; }
    asm volatile("s_waitcnt lgkmcnt(0)" ::: "memory");
    const int c = lane & 7;
#pragma unroll
    for (int j = 0; j < 4; ++j) { const int n = (lane >> 3) + 8 * j; const float* s = scr + (8 * c) * 33 + n;
        u32x4 o; o.x = pk2(s[0 * 33], s[1 * 33]); o.y = pk2(s[2 * 33], s[3 * 33]); o.z = pk2(s[4 * 33], s[5 * 33]); o.w = pk2(s[6 * 33], s[7 * 33]);
        *(u32x4*)(WT + (size_t)(dst_row0 + n) * K + k0 + 8 * c) = o; }
    asm volatile("s_waitcnt lgkmcnt(0)" ::: "memory");
}

__device__ __forceinline__ void phase0(const Args& a, unsigned char* lds) {
    const int tid = opaque_tid(), lane = tid & 63, wave = tid >> 6;
    const int gw = blockIdx.x * NWAVES + wave, NGW = gridDim.x * NWAVES;
    unsigned char* ws = a.ws;
    float* scr = (float*)(lds + wave * 16384);
    constexpr int I_A = 16 * 112, I_B = 16 * 32, I_C = 16 * 176, I_D = 44 * 32, NITEMS = I_A + I_B + I_C + I_D;
    for (int it = gw; it < NITEMS; it += NGW) {
        int r = it;
        if (r < I_A) { const int kb = r / 112, nb = r % 112; transpose_item(a.in[I_WIN], PROJW, 1024, (bf16*)(ws + WS_WIN), 32 * nb, 64 * kb, 32 * nb, nullptr, scr, lane); continue; } r -= I_A;
        if (r < I_B) { const int kb = r / 32, nb = r % 32; transpose_item(a.in[I_WOUT], 1024, 1024, (bf16*)(ws + WS_WOUT), 32 * nb, 64 * kb, 32 * nb, nullptr, scr, lane); continue; } r -= I_B;
        if (r < I_C) { const int kb = r / 176, nb = r % 176; const int n0 = 32 * nb, bj = n0 >= DFF ? 1 : 0, c0 = n0 - DFF * bj; const int dst = 256 * (c0 >> 7) + 128 * bj + (c0 & 127);
            transpose_item(a.in[I_WUP], 2 * DFF, 1024, (bf16*)(ws + WS_WUP), dst, 64 * kb, n0, a.in[I_FFNNW], scr, lane); continue; } r -= I_C;
        { const int kb = r / 32, nb = r % 32; transpose_item(a.in[I_WDOWN], 1024, DFF, (bf16*)(ws + WS_WDOWN), 32 * nb, 64 * kb, 32 * nb, nullptr, scr, lane); }
    }
    { float* z = (float*)(ws + WS_ROWSS); for (int i = blockIdx.x * NTHREADS + tid; i < 2 * T; i += gridDim.x * NTHREADS) z[i] = 0.f; }
    const float* x = a.in[I_X]; const float* win = a.in[I_WIN];
    float gwt[16][8]; f32x4 nw[4];
#pragma unroll
    for (int j = 0; j < 4; ++j) { nw[j] = *(const f32x4*)(a.in[I_MIXNW] + 256 * j + 4 * lane);
#pragma unroll
        for (int e = 0; e < 4; ++e) { const float* p = win + (size_t)(256 * j + 4 * lane + e) * PROJW + 3584; const f32x4 g0 = *(const f32x4*)p, g1 = *(const f32x4*)(p + 4);
            gwt[j * 4 + e][0] = g0[0]; gwt[j * 4 + e][1] = g0[1]; gwt[j * 4 + e][2] = g0[2]; gwt[j * 4 + e][3] = g0[3]; gwt[j * 4 + e][4] = g1[0]; gwt[j * 4 + e][5] = g1[1]; gwt[j * 4 + e][6] = g1[2]; gwt[j * 4 + e][7] = g1[3]; } }
    const float gbias = lane < 4 ? a.in[I_IB][lane] : (lane < 8 ? a.in[I_FB][lane - 4] : 0.f);
    bf16* XN = (bf16*)(ws + WS_XN); float* GATES = (float*)(ws + WS_GATES);
    f32x4 vn[4];
    { const f32x4* xr = (const f32x4*)(x + (size_t)gw * DM) + lane;
#pragma unroll
      for (int j = 0; j < 4; ++j) vn[j] = xr[64 * j]; }
    for (int m = gw; m < T; m += NGW) {
        f32x4 v[4]; float s = 0.f;
#pragma unroll
        for (int j = 0; j < 4; ++j) { v[j] = vn[j]; s += (v[j][0] * v[j][0] + v[j][1] * v[j][1]) + (v[j][2] * v[j][2] + v[j][3] * v[j][3]); }
        { const int mn = (m + NGW < T) ? m + NGW : m; const f32x4* xr = (const f32x4*)(x + (size_t)mn * DM) + lane;
#pragma unroll
          for (int j = 0; j < 4; ++j) vn[j] = xr[64 * j]; }
        const float rstd = rsqrtf(wave_sum(s) * (1.0f / DM) + EPS);
        float gs[8] = {0.f, 0.f, 0.f, 0.f, 0.f, 0.f, 0.f, 0.f};
        unsigned long long* o8 = (unsigned long long*)(XN + (size_t)m * DM) + lane;
#pragma unroll
        for (int j = 0; j < 4; ++j) { v[j] = v[j] * rstd * nw[j];
            o8[64 * j] = (unsigned long long)pk2(v[j][0], v[j][1]) | ((unsigned long long)pk2(v[j][2], v[j][3]) << 32);
#pragma unroll
            for (int e = 0; e < 4; ++e)
#pragma unroll
                for (int g = 0; g < 8; ++g) gs[g] += v[j][e] * gwt[j * 4 + e][g]; }
        float h4[4], h2[2], mine;
        { const bool up = (lane & 32) != 0;
#pragma unroll
          for (int i = 0; i < 4; ++i) { const float keep = up ? gs[4 + i] : gs[i], send = up ? gs[i] : gs[4 + i]; h4[i] = keep + __shfl_xor(send, 32); } }
        { const bool up = (lane & 16) != 0;
#pragma unroll
          for (int i = 0; i < 2; ++i) { const float keep = up ? h4[2 + i] : h4[i], send = up ? h4[i] : h4[2 + i]; h2[i] = keep + __shfl_xor(send, 16); } }
        { const bool up = (lane & 8) != 0; const float keep = up ? h2[1] : h2[0], send = up ? h2[0] : h2[1]; mine = keep + __shfl_xor(send, 8); }
        mine += __shfl_xor(mine, 4); mine += __shfl_xor(mine, 2); mine += __shfl_xor(mine, 1);
        { const int src = ((lane & 4) ? 32 : 0) | ((lane & 2) ? 16 : 0) | ((lane & 1) ? 8 : 0); mine = __shfl(mine, src); }
        if (lane < 8) { float z = mine + gbias; if (lane >= 4) z = (z >= 0.f) ? -log1pf(__expf(-z)) : (z - log1pf(__expf(z))); GATES[(size_t)m * 8 + lane] = z; }
    }
}

constexpr int AQ_STRIDE = 144, AV_STRIDE = 528;
constexpr int A_QS = 0, A_KS = 128 * AQ_STRIDE, A_VT = A_KS + 256 * AQ_STRIDE;
struct AttnRegs { u32x4 q[2], k[4], v[4]; };
struct AttnIdx { int grp, dil, blk, h; size_t tok0; };
__device__ __forceinline__ AttnIdx attn_decode(int u) {
    AttnIdx x; x.grp = u >> 11; int v = u & 2047; x.dil = x.grp == 0 ? 1 : (x.grp == 1 ? 4 : 16); const int nb = 32 / x.dil;
    x.blk = v % nb; v /= nb; const int r = v % x.dil; v /= x.dil; x.h = v & 7; const int b = v >> 3; x.tok0 = (size_t)b * SEQ + r; return x;
}
__device__ __forceinline__ void attn_load(AttnRegs& R, const bf16* AQ, const bf16* AK, const bf16* AV, int u, int tid) {
    const AttnIdx x = attn_decode(u);
#pragma unroll
    for (int i = 0; i < 2; ++i) { const int idx = tid + 512 * i, row = idx >> 3, ch = idx & 7; const size_t tok = x.tok0 + (size_t)(x.blk * 128 + row) * x.dil;
        R.q[i] = *(const u32x4*)(AQ + tok * 512 + x.h * 64 + ch * 8); }
#pragma unroll
    for (int i = 0; i < 4; ++i) { const int idx = tid + 512 * i, row = idx >> 3, ch = idx & 7; const int isub = (x.blk - 1) * 128 + row;
        u32x4 kv = {0u, 0u, 0u, 0u};
        if (isub >= 0) { const size_t tok = x.tok0 + (size_t)isub * x.dil; kv = *(const u32x4*)(AK + tok * 512 + x.h * 64 + ch * 8); }
        R.k[i] = kv; }
#pragma unroll
    for (int i = 0; i < 2; ++i) { const int idx = tid + 512 * i, rp = idx >> 3, ch = idx & 7;
#pragma unroll
        for (int q = 0; q < 2; ++q) { const int isub = (x.blk - 1) * 128 + 2 * rp + q; u32x4 vv = {0u, 0u, 0u, 0u};
            if (isub >= 0) { const size_t tok = x.tok0 + (size_t)isub * x.dil; vv = *(const u32x4*)(AV + tok * 512 + x.h * 64 + ch * 8); }
            R.v[2 * i + q] = vv; } }
}
__device__ __forceinline__ void attn_stage(const AttnRegs& R, unsigned char* lds, int tid) {
#pragma unroll
    for (int i = 0; i < 2; ++i) { const int idx = tid + 512 * i, row = idx >> 3, ch = idx & 7; *(u32x4*)(lds + A_QS + row * AQ_STRIDE + ch * 16) = R.q[i]; }
#pragma unroll
    for (int i = 0; i < 4; ++i) { const int idx = tid + 512 * i, row = idx >> 3, ch = idx & 7; *(u32x4*)(lds + A_KS + row * AQ_STRIDE + ch * 16) = R.k[i]; }
#pragma unroll
    for (int i = 0; i < 2; ++i) { const int idx = tid + 512 * i, rp = idx >> 3, ch = idx & 7; const u32x4 a = R.v[2 * i], c = R.v[2 * i + 1];
        unsigned* vt = (unsigned*)(lds + A_VT + (ch * 8) * AV_STRIDE + rp * 4);
#pragma unroll
        for (int wd = 0; wd < 4; ++wd) { vt[(2 * wd) * (AV_STRIDE / 4)] = (a[wd] & 0xffffu) | (c[wd] << 16); vt[(2 * wd + 1) * (AV_STRIDE / 4)] = (a[wd] >> 16) | (c[wd] & 0xffff0000u); } }
}
__device__ __forceinline__ void attn_compute(unsigned char* lds, bf16* OG, float* LSE, int u, const int tid) {
    const int lane = tid & 63, w = tid >> 6, l15 = lane & 15, g4 = lane >> 4;
    const AttnIdx x = attn_decode(u); const int grp = x.grp, dil = x.dil, blk = x.blk, h = x.h; const size_t tok0 = x.tok0;
    bf16x8 qf[2];
#pragma unroll
    for (int ks = 0; ks < 2; ++ks) qf[ks] = *(const bf16x8*)(lds + A_QS + (16 * w + l15) * AQ_STRIDE + ks * 64 + g4 * 16);
    f32x4 sc[9];
#pragma unroll
    for (int n = 0; n < 9; ++n) { f32x4 acc = {0.f, 0.f, 0.f, 0.f};
#pragma unroll
        for (int ks = 0; ks < 2; ++ks) { const bf16x8 kf = *(const bf16x8*)(lds + A_KS + (16 * (w + n) + l15) * AQ_STRIDE + ks * 64 + g4 * 16);
            acc = __builtin_amdgcn_mfma_f32_16x16x32_bf16(kf, qf[ks], acc, 0, 0, 0); }
        sc[n] = acc; }
    float mx = -INFINITY;
#pragma unroll
    for (int n = 0; n < 9; ++n)
#pragma unroll
        for (int j = 0; j < 4; ++j) { const int dk = 16 * n + 4 * g4 + j - l15; const int kj = 16 * (w + n) + 4 * g4 + j;
            const bool ok = (dk >= 0) && (dk <= 128) && (blk > 0 || kj >= 128);
            sc[n][j] = ok ? sc[n][j] : -INFINITY; mx = fmaxf(mx, sc[n][j]); }
    mx = fmaxf(mx, __shfl_xor(mx, 16)); mx = fmaxf(mx, __shfl_xor(mx, 32));
    float den = 0.f;
#pragma unroll
    for (int n = 0; n < 9; ++n)
#pragma unroll
        for (int j = 0; j < 4; ++j) { const float p = __expf(sc[n][j] - mx); sc[n][j] = p; den += p; }
    den += __shfl_xor(den, 16); den += __shfl_xor(den, 32);
    f32x4 o[4];
#pragma unroll
    for (int dt = 0; dt < 4; ++dt) o[dt] = (f32x4){0.f, 0.f, 0.f, 0.f};
#pragma unroll
    for (int s = 0; s < 5; ++s) {
        u32x4 pw; pw.x = pk2(sc[2 * s][0], sc[2 * s][1]); pw.y = pk2(sc[2 * s][2], sc[2 * s][3]);
        if (s < 4) { pw.z = pk2(sc[2 * s + 1][0], sc[2 * s + 1][1]); pw.w = pk2(sc[2 * s + 1][2], sc[2 * s + 1][3]); } else { pw.z = 0u; pw.w = 0u; }
        const bf16x8 pf = __builtin_bit_cast(bf16x8, pw);
        const int t0 = w + 2 * s; int t1 = w + 2 * s + 1; t1 = t1 > 15 ? 15 : t1;
#pragma unroll
        for (int dt = 0; dt < 4; ++dt) { const unsigned char* vrow = lds + A_VT + (16 * dt + l15) * AV_STRIDE + g4 * 8;
            u32x4 vw; const u32x2 lo = *(const u32x2*)(vrow + t0 * 32), hi = *(const u32x2*)(vrow + t1 * 32); vw.x = lo.x; vw.y = lo.y; vw.z = hi.x; vw.w = hi.y;
            o[dt] = __builtin_amdgcn_mfma_f32_16x16x32_bf16(__builtin_bit_cast(bf16x8, vw), pf, o[dt], 0, 0, 0); }
    }
    const float rden = 1.0f / den;
    const size_t tokq = tok0 + (size_t)(blk * 128 + 16 * w + l15) * dil;
    bf16* op = OG + ((size_t)grp * T + tokq) * 512 + h * 64 + 4 * g4;
#pragma unroll
    for (int dt = 0; dt < 4; ++dt) { u32x2 ov; ov.x = pk2(o[dt][0] * rden, o[dt][1] * rden); ov.y = pk2(o[dt][2] * rden, o[dt][3] * rden); *(u32x2*)(op + 16 * dt) = ov; }
    if (g4 == 0) LSE[((size_t)grp * T + tokq) * 8 + h] = mx + __logf(den);
}

constexpr int A2_QS = 0, A2_KS = 256 * AQ_STRIDE, A2_VSTRIDE = 784, A2_VT = A2_KS + 384 * AQ_STRIDE;
struct Attn2Regs { u32x4 q[4], k[6], v[6]; };
struct Attn2Idx { int grp, dil, blk0, h; size_t tok0; };
__device__ __forceinline__ Attn2Idx attn2_decode(int u) {
    Attn2Idx x; x.grp = u >> 10; int v = u & 1023; x.dil = x.grp == 0 ? 1 : (x.grp == 1 ? 4 : 16); const int nb2 = 16 / x.dil;
    x.blk0 = 2 * (v % nb2); v /= nb2; const int r = v % x.dil; v /= x.dil; x.h = v & 7; const int b = v >> 3; x.tok0 = (size_t)b * SEQ + r; return x;
}
__device__ __forceinline__ void attn2_load(Attn2Regs& R, const bf16* AQ, const bf16* AK, const bf16* AV, int u, int tid) {
    const Attn2Idx x = attn2_decode(u);
#pragma unroll
    for (int i = 0; i < 4; ++i) { const int idx = tid + 512 * i, row = idx >> 3, ch = idx & 7; const size_t tok = x.tok0 + (size_t)(x.blk0 * 128 + row) * x.dil;
        R.q[i] = *(const u32x4*)(AQ + tok * 512 + x.h * 64 + ch * 8); }
#pragma unroll
    for (int i = 0; i < 6; ++i) { const int idx = tid + 512 * i, row = idx >> 3, ch = idx & 7; const int isub = (x.blk0 - 1) * 128 + row;
        u32x4 kv = {0u, 0u, 0u, 0u};
        if (isub >= 0) { const size_t tok = x.tok0 + (size_t)isub * x.dil; kv = *(const u32x4*)(AK + tok * 512 + x.h * 64 + ch * 8); }
        R.k[i] = kv; }
#pragma unroll
    for (int i = 0; i < 3; ++i) { const int idx = tid + 512 * i, rp = idx >> 3, ch = idx & 7;
#pragma unroll
        for (int q = 0; q < 2; ++q) { const int isub = (x.blk0 - 1) * 128 + 2 * rp + q; u32x4 vv = {0u, 0u, 0u, 0u};
            if (isub >= 0) { const size_t tok = x.tok0 + (size_t)isub * x.dil; vv = *(const u32x4*)(AV + tok * 512 + x.h * 64 + ch * 8); }
            R.v[2 * i + q] = vv; } }
}
__device__ __forceinline__ void attn2_stage(const Attn2Regs& R, unsigned char* lds, int tid) {
#pragma unroll
    for (int i = 0; i < 4; ++i) { const int idx = tid + 512 * i, row = idx >> 3, ch = idx & 7; *(u32x4*)(lds + A2_QS + row * AQ_STRIDE + ch * 16) = R.q[i]; }
#pragma unroll
    for (int i = 0; i < 6; ++i) { const int idx = tid + 512 * i, row = idx >> 3, ch = idx & 7; *(u32x4*)(lds + A2_KS + row * AQ_STRIDE + ch * 16) = R.k[i]; }
#pragma unroll
    for (int i = 0; i < 3; ++i) { const int idx = tid + 512 * i, rp = idx >> 3, ch = idx & 7; const u32x4 a = R.v[2 * i], c = R.v[2 * i + 1];
        unsigned* vt = (unsigned*)(lds + A2_VT + (ch * 8) * A2_VSTRIDE + rp * 4);
#pragma unroll
        for (int wd = 0; wd < 4; ++wd) { vt[(2 * wd) * (A2_VSTRIDE / 4)] = (a[wd] & 0xffffu) | (c[wd] << 16); vt[(2 * wd + 1) * (A2_VSTRIDE / 4)] = (a[wd] >> 16) | (c[wd] & 0xffff0000u); } }
}
__device__ __forceinline__ void attn2_tile(unsigned char* lds, bf16* OG, float* LSE, const Attn2Idx& x, int tq, int l15, int g4) {
    bf16x8 qf[2];
#pragma unroll
    for (int ks = 0; ks < 2; ++ks) qf[ks] = *(const bf16x8*)(lds + A2_QS + (16 * tq + l15) * AQ_STRIDE + ks * 64 + g4 * 16);
    f32x4 sc[9];
#pragma unroll
    for (int n = 0; n < 9; ++n) { f32x4 acc = {0.f, 0.f, 0.f, 0.f};
#pragma unroll
        for (int ks = 0; ks < 2; ++ks) { const bf16x8 kf = *(const bf16x8*)(lds + A2_KS + (16 * (tq + n) + l15) * AQ_STRIDE + ks * 64 + g4 * 16);
            acc = __builtin_amdgcn_mfma_f32_16x16x32_bf16(kf, qf[ks], acc, 0, 0, 0); }
        sc[n] = acc; }
    float mx = -INFINITY;
#pragma unroll
    for (int n = 0; n < 9; ++n)
#pragma unroll
        for (int j = 0; j < 4; ++j) { const int dk = 16 * n + 4 * g4 + j - l15; const int kj = 16 * (tq + n) + 4 * g4 + j;
            const bool ok = (dk >= 0) && (dk <= 128) && (x.blk0 > 0 || kj >= 128);
            sc[n][j] = ok ? sc[n][j] : -INFINITY; mx = fmaxf(mx, sc[n][j]); }
    mx = fmaxf(mx, __shfl_xor(mx, 16)); mx = fmaxf(mx, __shfl_xor(mx, 32));
    float den = 0.f;
#pragma unroll
    for (int n = 0; n < 9; ++n)
#pragma unroll
        for (int j = 0; j < 4; ++j) { const float p = __expf(sc[n][j] - mx); sc[n][j] = p; den += p; }
    den += __shfl_xor(den, 16); den += __shfl_xor(den, 32);
    f32x4 o[4];
#pragma unroll
    for (int dt = 0; dt < 4; ++dt) o[dt] = (f32x4){0.f, 0.f, 0.f, 0.f};
#pragma unroll
    for (int s = 0; s < 5; ++s) {
        u32x4 pw; pw.x = pk2(sc[2 * s][0], sc[2 * s][1]); pw.y = pk2(sc[2 * s][2], sc[2 * s][3]);
        if (s < 4) { pw.z = pk2(sc[2 * s + 1][0], sc[2 * s + 1][1]); pw.w = pk2(sc[2 * s + 1][2], sc[2 * s + 1][3]); } else { pw.z = 0u; pw.w = 0u; }
        const bf16x8 pf = __builtin_bit_cast(bf16x8, pw);
        const int t0 = tq + 2 * s; int t1 = tq + 2 * s + 1; t1 = t1 > 23 ? 23 : t1;
#pragma unroll
        for (int dt = 0; dt < 4; ++dt) { const unsigned char* vrow = lds + A2_VT + (16 * dt + l15) * A2_VSTRIDE + g4 * 8;
            u32x4 vw; const u32x2 lo = *(const u32x2*)(vrow + t0 * 32), hi = *(const u32x2*)(vrow + t1 * 32); vw.x = lo.x; vw.y = lo.y; vw.z = hi.x; vw.w = hi.y;
            o[dt] = __builtin_amdgcn_mfma_f32_16x16x32_bf16(__builtin_bit_cast(bf16x8, vw), pf, o[dt], 0, 0, 0); }
    }
    const float rden = 1.0f / den;
    const size_t tokq = x.tok0 + (size_t)(x.blk0 * 128 + 16 * tq + l15) * x.dil;
    bf16* op = OG + ((size_t)x.grp * T + tokq) * 512 + x.h * 64 + 4 * g4;
#pragma unroll
    for (int dt = 0; dt < 4; ++dt) { u32x2 ov; ov.x = pk2(o[dt][0] * rden, o[dt][1] * rden); ov.y = pk2(o[dt][2] * rden, o[dt][3] * rden); *(u32x2*)(op + 16 * dt) = ov; }
    if (g4 == 0) LSE[((size_t)x.grp * T + tokq) * 8 + x.h] = mx + __logf(den);
}
__device__ __forceinline__ void attn2_compute(unsigned char* lds, bf16* OG, float* LSE, int u, const int tid) {
    const int lane = tid & 63, w = tid >> 6, l15 = lane & 15, g4 = lane >> 4;
    const Attn2Idx x = attn2_decode(u);
    attn2_tile(lds, OG, LSE, x, 2 * w, l15, g4);
    attn2_tile(lds, OG, LSE, x, 2 * w + 1, l15, g4);
}

__device__ __forceinline__ void attn_combine(const Args& a) {
    const int tid = opaque_tid(), lane = tid & 63, wave = tid >> 6;
    const int gw = blockIdx.x * NWAVES + wave, NGW = gridDim.x * NWAVES;
    const bf16* OG = (const bf16*)(a.ws + WS_OG); const float* LSE = (const float*)(a.ws + WS_LSE); bf16* Y = (bf16*)(a.ws + WS_Y);
    const int h = lane >> 3;
    const f32x4 nw0 = *(const f32x4*)(a.in[I_ANW] + 8 * lane), nw1 = *(const f32x4*)(a.in[I_ANW] + 8 * lane + 4);
    float lsn[3]; u32x4 ovn[3];
#pragma unroll
    for (int g = 0; g < 3; ++g) { lsn[g] = LSE[((size_t)g * T + gw) * 8 + h]; ovn[g] = *(const u32x4*)(OG + ((size_t)g * T + gw) * 512 + 8 * lane); }
    for (int t = gw; t < T; t += NGW) {
        float ls[3]; u32x4 ov[3];
#pragma unroll
        for (int g = 0; g < 3; ++g) { ls[g] = lsn[g]; ov[g] = ovn[g]; }
        { const int tn = (t + NGW < T) ? t + NGW : t;
#pragma unroll
          for (int g = 0; g < 3; ++g) { lsn[g] = LSE[((size_t)g * T + tn) * 8 + h]; ovn[g] = *(const u32x4*)(OG + ((size_t)g * T + tn) * 512 + 8 * lane); } }
        const float mm = fmaxf(ls[0], fmaxf(ls[1], ls[2]));
        float wt[3]; float sw = 0.f;
#pragma unroll
        for (int g = 0; g < 3; ++g) { wt[g] = __expf(ls[g] - mm); sw += wt[g]; }
        const float isw = 1.0f / sw;
        float val[8]; float ss = 0.f;
#pragma unroll
        for (int e = 0; e < 8; ++e) { float acc = 0.f;
#pragma unroll
            for (int g = 0; g < 3; ++g) { const unsigned wd = ov[g][e >> 1]; const float f = (e & 1) ? __uint_as_float(wd & 0xffff0000u) : __uint_as_float(wd << 16); acc += wt[g] * f; }
            val[e] = acc * isw; ss += val[e] * val[e]; }
        ss += __shfl_xor(ss, 1); ss += __shfl_xor(ss, 2); ss += __shfl_xor(ss, 4);
        const float rs = rsqrtf(ss * (1.0f / 64.0f) + EPS);
        u32x4 ow; ow.x = pk2(val[0] * rs * nw0[0], val[1] * rs * nw0[1]); ow.y = pk2(val[2] * rs * nw0[2], val[3] * rs * nw0[3]);
        ow.z = pk2(val[4] * rs * nw1[0], val[5] * rs * nw1[1]); ow.w = pk2(val[6] * rs * nw1[2], val[7] * rs * nw1[3]);
        *(u32x4*)(Y + (size_t)t * DM + 8 * lane) = ow;
    }
}

__device__ __forceinline__ int toff(int row, int chunk) { return row * 272 + (chunk << 4); }
constexpr int M_T0 = 0, M_T1 = 34816, M_T2 = 69632, M_T3 = 104448, M_AUX = 139264;
__device__ __forceinline__ float scan_add(float v, int lane) {
#pragma unroll
    for (int o = 1; o < 64; o <<= 1) { const float t = __shfl_up(v, o); if (lane >= o) v += t; }
    return v;
}
__device__ __forceinline__ float scan_max(float v, int lane) {
#pragma unroll
    for (int o = 1; o < 64; o <<= 1) { const float t = __shfl_up(v, o); if (lane >= o) v = fmaxf(v, t); }
    return v;
}
__device__ __forceinline__ void unpack8(const u32x4& v, float* f) {
#pragma unroll
    for (int e = 0; e < 4; ++e) { f[2 * e] = __uint_as_float(v[e] << 16); f[2 * e + 1] = __uint_as_float(v[e] & 0xffff0000u); }
}

__device__ __forceinline__ void mlstm_a(const Args& a, unsigned char* lds, int unit, const int tid) {
    const int lane = tid & 63, w = tid >> 6, l31 = lane & 31, hh = lane >> 5;
    const int c = unit & 31, h = (unit >> 5) & 3, b = unit >> 7;
    const size_t t0 = (size_t)b * SEQ + 128 * c;
    unsigned char* ws = a.ws;
    const float* GATES = (const float*)(ws + WS_GATES);
    float* wS = (float*)(lds + M_AUX);
    if (w == 0) {
        const float li0 = GATES[(t0 + 2 * lane) * 8 + h], li1 = GATES[(t0 + 2 * lane + 1) * 8 + h];
        const float lf0 = GATES[(t0 + 2 * lane) * 8 + 4 + h], lf1 = GATES[(t0 + 2 * lane + 1) * 8 + 4 + h];
        const float inc = scan_add(lf0 + lf1, lane); const float b1 = inc, b0 = inc - lf1;
        const float gtot = __shfl(inc, 63);
        const float a0 = gtot - b0 + li0, a1 = gtot - b1 + li1;
        const float amax = wave_max(fmaxf(a0, a1));
        wS[2 * lane] = __expf(a0 - amax); wS[2 * lane + 1] = __expf(a1 - amax);
        if (lane == 0) { float* chs = (float*)(ws + WS_CHS); chs[unit * 2] = gtot; chs[unit * 2 + 1] = amax; }
    }
    {
        const int cgi = tid & 31, rg = tid >> 5; const bool isk = cgi >= 16; const int chl = 8 * (cgi & 15);
        const bf16* src = (const bf16*)(ws + (isk ? WS_MKR : WS_MQR)) + h * 128 + chl;
        bf16* dst = (bf16*)(ws + (isk ? WS_MK : WS_MQ)) + h * 128 + chl;
        const float* cwp = a.in[I_MCW] + (isk ? 512 : 0) + h * 128 + chl; const float* cbp = a.in[I_MCB] + (isk ? 512 : 0) + h * 128 + chl;
        float wt[4][8], bs[8];
#pragma unroll
        for (int t = 0; t < 4; ++t) { const f32x4 w0 = *(const f32x4*)(cwp + t * 1024), w1 = *(const f32x4*)(cwp + t * 1024 + 4);
#pragma unroll
            for (int e = 0; e < 4; ++e) { wt[t][e] = w0[e]; wt[t][4 + e] = w1[e]; } }
        { const f32x4 b0 = *(const f32x4*)cbp, b1 = *(const f32x4*)(cbp + 4);
#pragma unroll
          for (int e = 0; e < 4; ++e) { bs[e] = b0[e]; bs[4 + e] = b1[e]; } }
        float xw[3][8];
#pragma unroll
        for (int p = 0; p < 3; ++p) { const int rr = 8 * rg - 3 + p; const bool ok = (c > 0) || (rr >= 0);
            u32x4 raw = {0u, 0u, 0u, 0u}; if (ok) raw = *(const u32x4*)(src + (size_t)((long)t0 + rr) * 512); unpack8(raw, xw[p]); }
        unsigned ktp[8][4];
#pragma unroll
        for (int i = 0; i < 8; ++i) { const int rr = 8 * rg + i; float xc[8]; { const u32x4 raw = *(const u32x4*)(src + (t0 + rr) * 512); unpack8(raw, xc); }
            float y[8];
#pragma unroll
            for (int e = 0; e < 8; ++e) { float s = bs[e] + wt[0][e] * xw[0][e] + wt[1][e] * xw[1][e] + wt[2][e] * xw[2][e] + wt[3][e] * xc[e]; s = pg8::silu_f(s); if (isk) s *= 0.08838834764831845f; y[e] = s;
                xw[0][e] = xw[1][e]; xw[1][e] = xw[2][e]; xw[2][e] = xc[e]; }
            u32x4 ov; ov.x = pk2(y[0], y[1]); ov.y = pk2(y[2], y[3]); ov.z = pk2(y[4], y[5]); ov.w = pk2(y[6], y[7]);
            *(u32x4*)(dst + (t0 + rr) * 512) = ov;
#pragma unroll
            for (int e = 0; e < 8; ++e) { if (i & 1) ktp[e][i >> 1] |= f2bf(y[e]) << 16; else ktp[e][i >> 1] = f2bf(y[e]); } }
        if (isk) {
#pragma unroll
            for (int e = 0; e < 8; ++e) { u32x4 pw; pw.x = ktp[e][0]; pw.y = ktp[e][1]; pw.z = ktp[e][2]; pw.w = ktp[e][3];
                *(u32x4*)(lds + M_T0 + toff(chl + e, rg)) = pw; }
        }
    }
    WG_SYNC();
    {
        const int vcg = tid & 15, vrg = tid >> 4; const bf16* src = (const bf16*)(ws + WS_MV) + h * 128 + 8 * vcg;
        float vv[4][8];
#pragma unroll
        for (int i = 0; i < 4; ++i) { const int rr = 4 * vrg + i; const u32x4 raw = *(const u32x4*)(src + (t0 + rr) * 512); unpack8(raw, vv[i]); const float sc = wS[rr];
#pragma unroll
            for (int e = 0; e < 8; ++e) vv[i][e] *= sc; }
#pragma unroll
        for (int e = 0; e < 8; ++e) { u32x2 pw; pw.x = pk2(vv[0][e], vv[1][e]); pw.y = pk2(vv[2][e], vv[3][e]);
            *(u32x2*)(lds + M_T1 + toff(8 * vcg + e, vrg >> 1) + (vrg & 1) * 8) = pw; }
    }
    if (tid < 128) { float acc = 0.f;
#pragma unroll 4
        for (int ch = 0; ch < 16; ++ch) { float f[8]; const u32x4 raw = *(const u32x4*)(lds + M_T0 + toff(tid, ch)); unpack8(raw, f);
#pragma unroll
            for (int e = 0; e < 8; ++e) acc += f[e] * wS[8 * ch + e]; }
        ((float*)(ws + WS_DN))[(size_t)unit * 128 + tid] = acc; }
    WG_SYNC();
    {
        const int vt = w >> 1; f32x16 acc[2];
#pragma unroll
        for (int i = 0; i < 2; ++i)
#pragma unroll
            for (int r = 0; r < 16; ++r) acc[i][r] = 0.f;
#pragma unroll
        for (int ks = 0; ks < 8; ++ks) { const bf16x8 af = *(const bf16x8*)(lds + M_T1 + toff(32 * vt + l31, 2 * ks + hh));
#pragma unroll
            for (int i = 0; i < 2; ++i) { const int ktile = 2 * (w & 1) + i; const bf16x8 bfr = *(const bf16x8*)(lds + M_T0 + toff(32 * ktile + l31, 2 * ks + hh));
                acc[i] = __builtin_amdgcn_mfma_f32_32x32x16_bf16(af, bfr, acc[i], 0, 0, 0); } }
#pragma unroll
        for (int i = 0; i < 2; ++i) { const int kcol = 32 * (2 * (w & 1) + i) + l31; unsigned char* sp = lds + M_T2 + toff(32 * vt + 4 * hh, kcol >> 3) + (kcol & 7) * 2;
#pragma unroll
            for (int r = 0; r < 16; ++r) *(unsigned short*)(sp + ((r & 3) + 8 * (r >> 2)) * 272) = (unsigned short)f2bf(acc[i][r]); }
    }
    WG_SYNC();
    { bf16* DC = (bf16*)(ws + WS_DC) + (size_t)unit * 16384;
#pragma unroll
      for (int i = 0; i < 4; ++i) { const int idx = tid + 512 * i, row = idx >> 4, ch = idx & 15; *(u32x4*)(DC + row * 128 + 8 * ch) = *(const u32x4*)(lds + M_T2 + toff(row, ch)); } }
    WG_SYNC();
}

__device__ __forceinline__ void mlstm_scan(const Args& a) {
    const int gt = blockIdx.x * NTHREADS + opaque_tid(), NT = gridDim.x * NTHREADS;
    unsigned char* ws = a.ws;
    const float* chs = (const float*)(ws + WS_CHS);
    for (int idx = gt; idx < 32 * 4096; idx += NT) {
        const int bh = idx >> 12, e4 = (idx & 4095) * 4;
        const bf16* DC = (const bf16*)(ws + WS_DC) + (size_t)bh * 32 * 16384 + e4; bf16* CH = (bf16*)(ws + WS_CH) + (size_t)bh * 32 * 16384 + e4;
        float cur[4] = {0.f, 0.f, 0.f, 0.f}; float M = 0.f;
#pragma unroll 4
        for (int c = 0; c < 32; ++c) {
            const u32x2 raw = *(const u32x2*)(DC + (size_t)c * 16384);
            u32x2 o; o.x = pk2(cur[0], cur[1]); o.y = pk2(cur[2], cur[3]); *(u32x2*)(CH + (size_t)c * 16384) = o;
            const float g = chs[(bh * 32 + c) * 2], am = chs[(bh * 32 + c) * 2 + 1];
            const float Mn = fmaxf(g + M, am); const float dec = __expf(g + M - Mn), sc = __expf(am - Mn);
            cur[0] = dec * cur[0] + sc * __uint_as_float(raw.x << 16); cur[1] = dec * cur[1] + sc * __uint_as_float(raw.x & 0xffff0000u);
            cur[2] = dec * cur[2] + sc * __uint_as_float(raw.y << 16); cur[3] = dec * cur[3] + sc * __uint_as_float(raw.y & 0xffff0000u);
            M = Mn;
        }
    }
    for (int idx = gt; idx < 32 * 128; idx += NT) {
        const int bh = idx >> 7, k = idx & 127;
        const float* DN = (const float*)(ws + WS_DN) + (size_t)bh * 32 * 128 + k; float* NH = (float*)(ws + WS_NH) + (size_t)bh * 32 * 128 + k; float* MC = (float*)(ws + WS_MC) + bh * 32;
        float cur = 0.f, M = 0.f;
        for (int c = 0; c < 32; ++c) {
            NH[c * 128] = cur; if (k == 0) MC[c] = M;
            const float g = chs[(bh * 32 + c) * 2], am = chs[(bh * 32 + c) * 2 + 1];
            const float Mn = fmaxf(g + M, am); cur = __expf(g + M - Mn) * cur + __expf(am - Mn) * DN[c * 128]; M = Mn;
        }
    }
}

__device__ __forceinline__ void mlstm_c(const Args& a, unsigned char* lds, int unit, const int tid) {
    const int lane = tid & 63, w = tid >> 6, l31 = lane & 31, hh = lane >> 5;
    const int c = unit & 31, h = (unit >> 5) & 3, b = unit >> 7;
    const size_t t0 = (size_t)b * SEQ + 128 * c;
    unsigned char* ws = a.ws;
    const float* GATES = (const float*)(ws + WS_GATES);
    float* uS = (float*)(lds + M_AUX);
    float* mxS = uS + 128;
    float* bS = uS + 256;
    float* nhS = uS + 384;
    float* rdS = uS + 512;
    const float Mc = ((const float*)(ws + WS_MC))[unit];
    if (w == 0) {
        const float li0 = GATES[(t0 + 2 * lane) * 8 + h], li1 = GATES[(t0 + 2 * lane + 1) * 8 + h];
        const float lf0 = GATES[(t0 + 2 * lane) * 8 + 4 + h], lf1 = GATES[(t0 + 2 * lane + 1) * 8 + 4 + h];
        const float inc = scan_add(lf0 + lf1, lane); const float b1 = inc, b0 = inc - lf1;
        const float u0 = li0 - b0, u1 = li1 - b1;
        const float pm = scan_max(fmaxf(u0, u1), lane); float pprev = __shfl_up(pm, 1); if (lane == 0) pprev = -INFINITY;
        const float pm0 = fmaxf(pprev, u0), pm1 = pm;
        uS[2 * lane] = u0; uS[2 * lane + 1] = u1; mxS[2 * lane] = fmaxf(Mc, pm0); mxS[2 * lane + 1] = fmaxf(Mc, pm1); bS[2 * lane] = b0; bS[2 * lane + 1] = b1;
    }
    if (w == 1) { nhS[lane] = ((const float*)(ws + WS_NH))[(size_t)unit * 128 + lane]; nhS[64 + lane] = ((const float*)(ws + WS_NH))[(size_t)unit * 128 + 64 + lane]; }
    {
        const bf16* MQ = (const bf16*)(ws + WS_MQ) + h * 128; const bf16* MK = (const bf16*)(ws + WS_MK) + h * 128; const bf16* CH = (const bf16*)(ws + WS_CH) + (size_t)unit * 16384;
#pragma unroll
        for (int i = 0; i < 4; ++i) { const int idx = tid + 512 * i, row = idx >> 4, ch = idx & 15;
            *(u32x4*)(lds + M_T0 + toff(row, ch)) = *(const u32x4*)(MQ + (t0 + row) * 512 + 8 * ch);
            *(u32x4*)(lds + M_T1 + toff(row, ch)) = *(const u32x4*)(MK + (t0 + row) * 512 + 8 * ch);
            *(u32x4*)(lds + M_T3 + toff(row, ch)) = *(const u32x4*)(CH + row * 128 + 8 * ch); }
        const int vcg = tid & 15, vrg = tid >> 4; const bf16* src = (const bf16*)(ws + WS_MV) + h * 128 + 8 * vcg;
        u32x4 raw[4];
#pragma unroll
        for (int i = 0; i < 4; ++i) raw[i] = *(const u32x4*)(src + (t0 + 4 * vrg + i) * 512);
#pragma unroll
        for (int e = 0; e < 8; ++e) { const int wd = e >> 1; u32x2 pw;
            if (e & 1) { pw.x = (raw[0][wd] >> 16) | (raw[1][wd] & 0xffff0000u); pw.y = (raw[2][wd] >> 16) | (raw[3][wd] & 0xffff0000u); }
            else { pw.x = (raw[0][wd] & 0xffffu) | (raw[1][wd] << 16); pw.y = (raw[2][wd] & 0xffffu) | (raw[3][wd] << 16); }
            *(u32x2*)(lds + M_T2 + toff(8 * vcg + e, vrg >> 1) + (vrg & 1) * 8) = pw; }
    }
    WG_SYNC();
    const int ti = w >> 1;
    f32x16 sacc[2];
#pragma unroll
    for (int i = 0; i < 2; ++i) {
#pragma unroll
        for (int r = 0; r < 16; ++r) sacc[i][r] = 0.f;
        const int si = 2 * (w & 1) + i;
        if (si <= ti) {
#pragma unroll
            for (int ks = 0; ks < 8; ++ks) { const bf16x8 af = *(const bf16x8*)(lds + M_T0 + toff(32 * ti + l31, 2 * ks + hh)); const bf16x8 bfr = *(const bf16x8*)(lds + M_T1 + toff(32 * si + l31, 2 * ks + hh));
                sacc[i] = __builtin_amdgcn_mfma_f32_32x32x16_bf16(af, bfr, sacc[i], 0, 0, 0); }
        }
    }
    WG_SYNC();
#pragma unroll
    for (int i = 0; i < 2; ++i) { const int si = 2 * (w & 1) + i;
        if (si <= ti) { const int s = 32 * si + l31; const float us = uS[s];
#pragma unroll
            for (int r = 0; r < 16; ++r) { const int t = 32 * ti + (r & 3) + 8 * (r >> 2) + 4 * hh; const float p = (s <= t) ? sacc[i][r] * __expf(us - mxS[t]) : 0.f;
                *(unsigned short*)(lds + M_T1 + toff(t, s >> 3) + (s & 7) * 2) = (unsigned short)f2bf(p); } } }
    WG_SYNC();
    { const int t = tid >> 2, part = tid & 3, tb = t >> 5; float rsum = 0.f, qn = 0.f;
        for (int ch = part; ch < 4 * (tb + 1); ch += 4) { float f[8]; const u32x4 raw = *(const u32x4*)(lds + M_T1 + toff(t, ch)); unpack8(raw, f);
#pragma unroll
            for (int e = 0; e < 8; ++e) rsum += f[e]; }
        const float inter = __expf(Mc - mxS[t]);
#pragma unroll
        for (int c4 = 0; c4 < 4; ++c4) { const int ch = 4 * part + c4; float f[8]; const u32x4 raw = *(const u32x4*)(lds + M_T0 + toff(t, ch)); unpack8(raw, f);
#pragma unroll
            for (int e = 0; e < 8; ++e) { qn += f[e] * nhS[8 * ch + e]; f[e] *= inter; }
            u32x4 ov; ov.x = pk2(f[0], f[1]); ov.y = pk2(f[2], f[3]); ov.z = pk2(f[4], f[5]); ov.w = pk2(f[6], f[7]); *(u32x4*)(lds + M_T0 + toff(t, ch)) = ov; }
        rsum += __shfl_xor(rsum, 1); rsum += __shfl_xor(rsum, 2); qn += __shfl_xor(qn, 1); qn += __shfl_xor(qn, 2);
        const float den = rsum + inter * qn; const float mt = bS[t] + mxS[t];
        if (part == 0) rdS[t] = 1.0f / fmaxf(fabsf(den), __expf(-mt)); }
    WG_SYNC();
    f32x16 hacc[2];
#pragma unroll
    for (int i = 0; i < 2; ++i)
#pragma unroll
        for (int r = 0; r < 16; ++r) hacc[i][r] = 0.f;
    for (int ks = 0; ks < 2 * (ti + 1); ++ks) { const bf16x8 af = *(const bf16x8*)(lds + M_T1 + toff(32 * ti + l31, 2 * ks + hh));
#pragma unroll
        for (int i = 0; i < 2; ++i) { const int vt = 2 * (w & 1) + i; const bf16x8 bfr = *(const bf16x8*)(lds + M_T2 + toff(32 * vt + l31, 2 * ks + hh));
            hacc[i] = __builtin_amdgcn_mfma_f32_32x32x16_bf16(af, bfr, hacc[i], 0, 0, 0); } }
#pragma unroll
    for (int ks = 0; ks < 8; ++ks) { const bf16x8 af = *(const bf16x8*)(lds + M_T0 + toff(32 * ti + l31, 2 * ks + hh));
#pragma unroll
        for (int i = 0; i < 2; ++i) { const int vt = 2 * (w & 1) + i; const bf16x8 bfr = *(const bf16x8*)(lds + M_T3 + toff(32 * vt + l31, 2 * ks + hh));
            hacc[i] = __builtin_amdgcn_mfma_f32_32x32x16_bf16(af, bfr, hacc[i], 0, 0, 0); } }
    WG_SYNC();
    float* hS = (float*)lds;
#pragma unroll
    for (int i = 0; i < 2; ++i) { const int v = 32 * (2 * (w & 1) + i) + l31;
#pragma unroll
        for (int r = 0; r < 16; ++r) { const int t = 32 * ti + (r & 3) + 8 * (r >> 2) + 4 * hh; hS[t * 132 + v] = hacc[i][r] * rdS[t]; } }
    WG_SYNC();
    { const int t = tid >> 2, part = tid & 3; float hv[32]; float ss = 0.f;
#pragma unroll
        for (int q = 0; q < 8; ++q) { const f32x4 x4 = *(const f32x4*)(hS + t * 132 + 32 * part + 4 * q); hv[4 * q] = x4[0]; hv[4 * q + 1] = x4[1]; hv[4 * q + 2] = x4[2]; hv[4 * q + 3] = x4[3];
            ss += (x4[0] * x4[0] + x4[1] * x4[1]) + (x4[2] * x4[2] + x4[3] * x4[3]); }
        ss += __shfl_xor(ss, 1); ss += __shfl_xor(ss, 2);
        const float rs = rsqrtf(ss * (1.0f / 128.0f) + EPS);
        const float* nw = a.in[I_MNW] + h * 128 + 32 * part; const bf16* MO = (const bf16*)(ws + WS_MO) + (t0 + t) * 512 + h * 128 + 32 * part;
        bf16* Y = (bf16*)(ws + WS_Y) + (t0 + t) * DM + 512 + h * 128 + 32 * part;
#pragma unroll
        for (int q = 0; q < 4; ++q) { float og[8]; const u32x4 raw = *(const u32x4*)(MO + 8 * q); unpack8(raw, og); const f32x4 n0 = *(const f32x4*)(nw + 8 * q), n1 = *(const f32x4*)(nw + 8 * q + 4);
            float r8[8];
#pragma unroll
            for (int e = 0; e < 8; ++e) { const float nwv = e < 4 ? n0[e] : n1[e - 4]; const float sg = __builtin_amdgcn_rcpf(1.0f + __expf(-og[e])); r8[e] = hv[8 * q + e] * rs * nwv * sg;
#ifdef DBG_ZERO_ML
                r8[e] = 0.f;
#endif
            }
            u32x4 ov; ov.x = pk2(r8[0], r8[1]); ov.y = pk2(r8[2], r8[3]); ov.z = pk2(r8[4], r8[5]); ov.w = pk2(r8[6], r8[7]); *(u32x4*)(Y + 8 * q) = ov; } }
    WG_SYNC();
}

__device__ __forceinline__ void ffn_fixup(const Args& a) {
    const int gt = blockIdx.x * NTHREADS + opaque_tid(), NT = gridDim.x * NTHREADS;
    const float* EDGE = (const float*)(a.ws + WS_EDGE); bf16* G = (bf16*)(a.ws + WS_G); const float* cw = a.in[I_FCW]; const float* cb = a.in[I_FCB];
    for (int idx = gt; idx < 128 * 2 * DFF; idx += NT) {
        const int ch = idx % DFF; const int rr = (idx / DFF) & 1; const int pm = idx / (2 * DFF);
        if ((pm & 15) == 0) continue;
        const int tcg = 256 * (ch >> 7) + (ch & 127), tcv = tcg + 128;
        const float* e_cur = EDGE + ((size_t)pm * 4 + rr) * 5632; const float* e_p1 = rr ? EDGE + ((size_t)pm * 4 + 0) * 5632 : EDGE + ((size_t)(pm - 1) * 4 + 3) * 5632;
        const float* e_p2 = rr ? EDGE + ((size_t)(pm - 1) * 4 + 3) * 5632 : EDGE + ((size_t)(pm - 1) * 4 + 2) * 5632;
        const float yg = cb[ch] + cw[ch] * e_p2[tcg] + cw[5632 + ch] * e_p1[tcg] + cw[2 * 5632 + ch] * e_cur[tcg];
        const float yv = cb[DFF + ch] + cw[DFF + ch] * e_p2[tcv] + cw[5632 + DFF + ch] * e_p1[tcv] + cw[2 * 5632 + DFF + ch] * e_cur[tcv];
        G[(size_t)(pm * 256 + rr) * DFF + ch] = (bf16)f2bf(pg8::silu_f(yg) * yv);
    }
}

__device__ __forceinline__ void ffn_fixup_tile(const Args& a, int pm, int tid) {
    if ((pm & 15) == 0) return;
    const float* EDGE = (const float*)(a.ws + WS_EDGE); bf16* G = (bf16*)(a.ws + WS_G); const float* cw = a.in[I_FCW]; const float* cb = a.in[I_FCB];
    for (int idx = tid; idx < 2 * DFF; idx += NTHREADS) {
        const int ch = idx % DFF; const int rr = idx / DFF;
        const int tcg = 256 * (ch >> 7) + (ch & 127), tcv = tcg + 128;
        const float* e_cur = EDGE + ((size_t)pm * 4 + rr) * 5632; const float* e_p1 = rr ? EDGE + ((size_t)pm * 4 + 0) * 5632 : EDGE + ((size_t)(pm - 1) * 4 + 3) * 5632;
        const float* e_p2 = rr ? EDGE + ((size_t)(pm - 1) * 4 + 3) * 5632 : EDGE + ((size_t)(pm - 1) * 4 + 2) * 5632;
        const float yg = cb[ch] + cw[ch] * e_p2[tcg] + cw[5632 + ch] * e_p1[tcg] + cw[2 * 5632 + ch] * e_cur[tcg];
        const float yv = cb[DFF + ch] + cw[DFF + ch] * e_p2[tcv] + cw[5632 + DFF + ch] * e_p1[tcv] + cw[2 * 5632 + DFF + ch] * e_cur[tcv];
        G[(size_t)(pm * 256 + rr) * DFF + ch] = (bf16)f2bf(pg8::silu_f(yg) * yv);
    }
}

__device__ __forceinline__ void final_norm(const Args& a, float* outp) {
    const int tid = opaque_tid(), lane = tid & 63, wave = tid >> 6;
    const int gw = blockIdx.x * NWAVES + wave, NGW = gridDim.x * NWAVES;
    const float* rowss2 = (const float*)(a.ws + WS_ROWSS2);
    f32x4 nw[4];
#pragma unroll
    for (int j = 0; j < 4; ++j) nw[j] = *(const f32x4*)(a.in[I_FINW] + 256 * j + 4 * lane);
    for (int m0 = 4 * gw; m0 < T; m0 += 4 * NGW) {
        f32x4 v[4][4]; float rs[4];
#pragma unroll
        for (int q = 0; q < 4; ++q) { rs[q] = rsqrtf(rowss2[m0 + q] * (1.0f / DM) + EPS);
#ifdef H_BF16
            const u32x2* xb = (const u32x2*)((const bf16*)(a.ws + WS_H1B) + (size_t)(m0 + q) * DM) + lane;
#pragma unroll
            for (int j = 0; j < 4; ++j) { const u32x2 t = xb[64 * j]; v[q][j] = (f32x4){__uint_as_float(t.x << 16), __uint_as_float(t.x & 0xffff0000u), __uint_as_float(t.y << 16), __uint_as_float(t.y & 0xffff0000u)}; }
#else
            const f32x4* xr = (const f32x4*)(outp + (size_t)(m0 + q) * DM) + lane;
#pragma unroll
            for (int j = 0; j < 4; ++j) v[q][j] = xr[64 * j];
#endif
        }
#pragma unroll
        for (int q = 0; q < 4; ++q) { f32x4* xr = (f32x4*)(outp + (size_t)(m0 + q) * DM) + lane;
#pragma unroll
            for (int j = 0; j < 4; ++j) xr[64 * j] = v[q][j] * rs[q] * nw[j]; }
    }
}

#define XB_TMO      128
#define XB_XCNT(j)  (256  + 64 * (j))
#define XB_XSUB(j)  (1280 + 64 * (j))
#define XB_XGEN(j)  (2304 + 64 * (j))
#define XB_TOP      3328
#define XB_TOPGEN   3392
#define XCD_BAR_WORDS 3456
#define XB_SPIN_CAP (1u << 23)

__device__ __forceinline__ unsigned xb_ld(unsigned* p)              { return __hip_atomic_load(p, __ATOMIC_RELAXED, __HIP_MEMORY_SCOPE_AGENT); }
__device__ __forceinline__ unsigned xb_add(unsigned* p, unsigned v) { return __hip_atomic_fetch_add(p, v, __ATOMIC_RELAXED, __HIP_MEMORY_SCOPE_AGENT); }
__device__ __forceinline__ unsigned xb_xcc_id() { return (unsigned)__builtin_amdgcn_s_getreg((3 << 11) | 20) & 0xFu; }
#define XB_SPIN(cond, bar) do { unsigned _sp = 0; while (cond) { __builtin_amdgcn_s_sleep(1); \
    if ((++_sp & 255u) == 0u) { if (xb_ld(&(bar)[XB_TMO])) break; if (_sp > XB_SPIN_CAP) { atomicAdd(&(bar)[XB_TMO], 1u); break; } } } } while (0)

struct XcdBarrier {
    unsigned* bar; unsigned x;
    volatile LAS unsigned* st;
};

__device__ __forceinline__ XcdBarrier xcd_barrier_post(unsigned* bar, volatile LAS unsigned* st) {
    XcdBarrier b; b.bar = bar; b.x = xb_xcc_id(); b.st = st;
    if (threadIdx.x == 0) (void)xb_add(&bar[XB_XCNT(b.x)], 1u);
    return b;
}
__device__ __forceinline__ void xcd_barrier_complete(unsigned* bar, unsigned x, unsigned& nloc, unsigned& nx) {
    const unsigned G = gridDim.x * gridDim.y * gridDim.z;
    unsigned sum, cnt, mine, sp = 0u;
    for (;;) {
        sum = 0u; cnt = 0u; mine = 0u;
#pragma unroll
        for (unsigned j = 0; j < 16; ++j) { const unsigned c = xb_ld(&bar[XB_XCNT(j)]); sum += c; cnt += (c > 0u) ? 1u : 0u; mine = (j == x) ? c : mine; }
        if (sum == G) break;
        __builtin_amdgcn_s_sleep(1);
        if ((++sp & 255u) == 0u) { if (xb_ld(&bar[XB_TMO])) break; if (sp > XB_SPIN_CAP) { atomicAdd(&bar[XB_TMO], 1u); break; } }
    }
    nloc = mine > 0u ? mine : 1u; nx = cnt > 0u ? cnt : 1u;
}

__device__ __forceinline__ void xcd_barrier(const XcdBarrier& b) {
    asm volatile("s_waitcnt vmcnt(0)" ::: "memory");
    __syncthreads();
    if (threadIdx.x == 0) {
        unsigned* bar = b.bar;
        __builtin_amdgcn_s_waitcnt(0);
        unsigned nloc = b.st[0], nx = b.st[1];
        if (nloc == 0u) { xcd_barrier_complete(bar, b.x, nloc, nx); b.st[0] = nloc; b.st[1] = nx; }
        const unsigned old = xb_add(&bar[XB_XSUB(b.x)], 1u);
        const unsigned gen = old / nloc;
        if (old + 1u == (gen + 1u) * nloc) {
            __builtin_amdgcn_fence(__ATOMIC_RELEASE, "agent");
            asm volatile("s_waitcnt vmcnt(0)" ::: "memory");
            const unsigned og = xb_add(&bar[XB_TOP], 1u);
            const unsigned tg = og / nx;
            if (og + 1u == (tg + 1u) * nx) xb_add(&bar[XB_TOPGEN], 1u);
            else XB_SPIN(xb_ld(&bar[XB_TOPGEN]) == tg, bar);
            __builtin_amdgcn_fence(__ATOMIC_ACQUIRE, "agent");
            xb_add(&bar[XB_XGEN(b.x)], 1u);
            asm volatile("s_waitcnt vmcnt(0)" ::: "memory");
        } else {
            XB_SPIN(xb_ld(&bar[XB_XGEN(b.x)]) == gen, bar);
            __builtin_amdgcn_fence(__ATOMIC_ACQUIRE, "agent");
            asm volatile("s_waitcnt vmcnt(0)" ::: "memory");
        }
    }
    __syncthreads();
}

#ifdef USE_CG_SYNC
#define GSYNC() grid.sync()
#else
#define GSYNC() xcd_barrier(xbar)
#endif
constexpr int CV_SEG = 32, CV_NSEG = T / CV_SEG, CV_NCG = DFF / 8, CV_ITEMS = CV_NSEG * CV_NCG, CV_MAXIT = 3;
__device__ __forceinline__ void ffn_conv_inplace(const Args& a, cg::grid_group& grid, const XcdBarrier& xbar) {
    const int gt = blockIdx.x * NTHREADS + opaque_tid(), NT = gridDim.x * NTHREADS;
    bf16* U = (bf16*)(a.ws + WS_U); const float* cw = a.in[I_FCW]; const float* cb = a.in[I_FCB];
    u32x4 hal[CV_MAXIT][2];
#pragma unroll
    for (int it = 0; it < CV_MAXIT; ++it) { const int item = gt + it * NT; hal[it][0] = (u32x4){0u, 0u, 0u, 0u}; hal[it][1] = hal[it][0];
        if (item < CV_ITEMS) { const int cgp = item % CV_NCG, seg = item / CV_NCG; const int t0 = seg * CV_SEG;
            if ((t0 & (SEQ - 1)) != 0) { hal[it][0] = *(const u32x4*)(U + (size_t)(t0 - 2) * 5632 + 8 * cgp); hal[it][1] = *(const u32x4*)(U + (size_t)(t0 - 1) * 5632 + 8 * cgp); } } }
    GSYNC();
#pragma unroll
    for (int it = 0; it < CV_MAXIT; ++it) { const int item = gt + it * NT;
        if (item < CV_ITEMS) { const int cgp = item % CV_NCG, seg = item / CV_NCG; const int t0 = seg * CV_SEG; const int ch = 8 * cgp;
            float wg[3][8], wv[3][8], bg[8], bv[8];
#pragma unroll
            for (int t = 0; t < 3; ++t) { const f32x4 a0 = *(const f32x4*)(cw + t * 5632 + ch), a1 = *(const f32x4*)(cw + t * 5632 + ch + 4), c0 = *(const f32x4*)(cw + t * 5632 + DFF + ch), c1 = *(const f32x4*)(cw + t * 5632 + DFF + ch + 4);
#pragma unroll
                for (int e = 0; e < 4; ++e) { wg[t][e] = a0[e]; wg[t][4 + e] = a1[e]; wv[t][e] = c0[e]; wv[t][4 + e] = c1[e]; } }
            { const f32x4 a0 = *(const f32x4*)(cb + ch), a1 = *(const f32x4*)(cb + ch + 4), c0 = *(const f32x4*)(cb + DFF + ch), c1 = *(const f32x4*)(cb + DFF + ch + 4);
#pragma unroll
              for (int e = 0; e < 4; ++e) { bg[e] = a0[e]; bg[4 + e] = a1[e]; bv[e] = c0[e]; bv[4 + e] = c1[e]; } }
            float g2[8], g1[8], v2[8], v1[8];
            unpack8(hal[it][0], g2); unpack8(hal[it][1], g1);
            { u32x4 r2 = {0u, 0u, 0u, 0u}, r1 = r2; if ((t0 & (SEQ - 1)) != 0) { r2 = *(const u32x4*)(U + (size_t)(t0 - 2) * 5632 + DFF + ch); r1 = *(const u32x4*)(U + (size_t)(t0 - 1) * 5632 + DFF + ch); } unpack8(r2, v2); unpack8(r1, v1); }
            bf16* up = U + (size_t)t0 * 5632 + ch;
            for (int r0 = 0; r0 < CV_SEG; r0 += 4) {
                u32x4 rg[4], rv[4];
#pragma unroll
                for (int i = 0; i < 4; ++i) { rg[i] = *(const u32x4*)(up + (size_t)(r0 + i) * 5632); rv[i] = *(const u32x4*)(up + (size_t)(r0 + i) * 5632 + DFF); }
#pragma unroll
                for (int i = 0; i < 4; ++i) { float gc[8], vc[8]; unpack8(rg[i], gc); unpack8(rv[i], vc);
                    float o[8];
#pragma unroll
                    for (int e = 0; e < 8; ++e) { const float yg = bg[e] + wg[0][e] * g2[e] + wg[1][e] * g1[e] + wg[2][e] * gc[e]; const float yv = bv[e] + wv[0][e] * v2[e] + wv[1][e] * v1[e] + wv[2][e] * vc[e];
                        o[e] = pg8::silu_f(yg) * yv; g2[e] = g1[e]; g1[e] = gc[e]; v2[e] = v1[e]; v1[e] = vc[e]; }
                    u32x4 ow; ow.x = pk2(o[0], o[1]); ow.y = pk2(o[2], o[3]); ow.z = pk2(o[4], o[5]); ow.w = pk2(o[6], o[7]); *(u32x4*)(up + (size_t)(r0 + i) * 5632) = ow; }
            }
        } }
}

__global__ void __launch_bounds__(NTHREADS, 2) hymba_fwd(Args args) {
    extern __shared__ __attribute__((aligned(16))) unsigned char lds[];
    cg::grid_group grid = cg::this_grid();
    unsigned char* ws = args.ws;
    const int G = gridDim.x, bx = blockIdx.x;
    const int vcu = (G % 8 == 0) ? (bx % 8) * (G / 8) + bx / 8 : bx;
    LAS unsigned char* ldsl = (LAS unsigned char*)lds;
    volatile LAS unsigned* bst = (volatile LAS unsigned*)(ldsl + LDS_BYTES - 64);
    if (threadIdx.x == 0) { bst[0] = 0u; bst[1] = 0u; }
    __syncthreads();
    XcdBarrier xbar = xcd_barrier_post((unsigned*)(ws + WS_BAR), bst);

#ifndef REP_P0
#define REP_P0 1
#endif
    for (int rep_ = 0; rep_ < REP_P0; ++rep_) phase0(args, lds);
    grid.sync();
#ifndef REP_P1
#define REP_P1 1
#endif
    for (int rep_ = 0; rep_ < REP_P1; ++rep_)
    { pg8::Gemm g{(const pg8::bf16_t*)(ws + WS_XN), (const pg8::bf16_t*)(ws + WS_WIN), T, 3584, 1024, 1024}; pg8::StaticOrder S; S.init(T, 3584, G, bx);
      pg8::EpiBf16<0> E{(pg8::bf16_t*)(ws + WS_AQ), 512, nullptr, 512, (size_t)(WS_AK - WS_AQ) / 2, 0.125f};
      pg8::gemm_phase<pg8::EpiBf16<0>, pg8::StaticOrder, true, true>(ldsl, g, S, E); }
    GSYNC();
#ifndef REP_MA
#define REP_MA 1
#endif
    for (int rep_ = 0; rep_ < REP_MA; ++rep_)
    { const int tid2a = opaque_tid(); for (int u = bx; u < 1024; u += G) mlstm_a(args, lds, u, tid2a); }
#ifndef REP_ATT
#define REP_ATT 1
#endif
#ifdef ATT2
    { const int tid2a = opaque_tid(); const bf16* AQp = (const bf16*)(ws + WS_AQ); const bf16* AKp = (const bf16*)(ws + WS_AK); const bf16* AVp = (const bf16*)(ws + WS_AV);
      Attn2Regs R; attn2_load(R, AQp, AKp, AVp, bx, tid2a);
      for (int u = bx; u < 3072; u += G) {
          attn2_stage(R, lds, tid2a);
          WG_SYNC();
          if (u + G < 3072) attn2_load(R, AQp, AKp, AVp, u + G, tid2a);
          attn2_compute(lds, (bf16*)(ws + WS_OG), (float*)(ws + WS_LSE), u, tid2a);
          WG_SYNC();
      } }
#else
    for (int rep_ = 0; rep_ < REP_ATT; ++rep_)
    { const int tid2a = opaque_tid(); const bf16* AQp = (const bf16*)(ws + WS_AQ); const bf16* AKp = (const bf16*)(ws + WS_AK); const bf16* AVp = (const bf16*)(ws + WS_AV);
      AttnRegs R; attn_load(R, AQp, AKp, AVp, bx, tid2a);
      for (int u = bx; u < 6144; u += G) {
          attn_stage(R, lds, tid2a);
          WG_SYNC();
          if (u + G < 6144) attn_load(R, AQp, AKp, AVp, u + G, tid2a);
          attn_compute(lds, (bf16*)(ws + WS_OG), (float*)(ws + WS_LSE), u, tid2a);
          WG_SYNC();
      } }
#endif
    GSYNC();
#ifndef REP_SCAN
#define REP_SCAN 1
#endif
    for (int rep_ = 0; rep_ < REP_SCAN; ++rep_) mlstm_scan(args);
    GSYNC();
#ifndef REP_MC
#define REP_MC 1
#endif
#ifndef REP_CMB
#define REP_CMB 1
#endif
    for (int rep_ = 0; rep_ < REP_MC; ++rep_)
    { const int tid2c = opaque_tid(); for (int u = bx; u < 1024; u += G) mlstm_c(args, lds, u, tid2c); }
    for (int rep_ = 0; rep_ < REP_CMB; ++rep_) attn_combine(args);
    GSYNC();
    { pg8::Gemm g{(const pg8::bf16_t*)(ws + WS_Y), (const pg8::bf16_t*)(ws + WS_WOUT), T, 1024, 1024, 1024}; pg8::StaticOrder S; S.init(T, 1024, G, bx);
      pg8::EpiOut E{args.in[I_X], args.out, (pg8::bf16_t*)(ws + WS_H1B), (float*)(ws + WS_ROWSS)};
      pg8::gemm_phase<pg8::EpiOut, pg8::StaticOrder, true, true>(ldsl, g, S, E); }
#ifdef PROBE_DUMMY
    { pg8::Gemm g{(const pg8::bf16_t*)(ws + WS_Y), (const pg8::bf16_t*)(ws + WS_WOUT), T, 1024, 1024, 1024}; pg8::StaticOrder S; S.init(T, 1024, G, bx);
      pg8::EpiOut E{args.in[I_X], (float*)(ws + WS_MQR), (pg8::bf16_t*)(ws + WS_MQ), (float*)(ws + WS_DC)};
      pg8::gemm_phase<pg8::EpiOut, pg8::StaticOrder, true, true>(ldsl, g, S, E); }
#endif
    GSYNC();
#ifdef FFN_UNFUSED
#ifdef PROBE_CONV
    ffn_conv_inplace(args, grid, xbar);
    GSYNC();
#endif
#ifndef REP_P4
#define REP_P4 1
#endif
    for (int rep_ = 0; rep_ < REP_P4; ++rep_)
    { pg8::Gemm g{(const pg8::bf16_t*)(ws + WS_H1B), (const pg8::bf16_t*)(ws + WS_WUP), T, 2 * DFF, 1024, 1024}; pg8::StaticOrder S; S.init(T, 2 * DFF, G, bx);
      pg8::EpiUpRaw E{(pg8::bf16_t*)(ws + WS_U), (const float*)(ws + WS_ROWSS)};
      pg8::gemm_phase<pg8::EpiUpRaw, pg8::StaticOrder, true, true>(ldsl, g, S, E); }
    GSYNC();
    ffn_conv_inplace(args, grid, xbar);
    GSYNC();
#else
    { pg8::Gemm g{(const pg8::bf16_t*)(ws + WS_H1B), (const pg8::bf16_t*)(ws + WS_WUP), T, 2 * DFF, 1024, 1024}; pg8::StaticOrder S; S.init(T, 2 * DFF, G, bx);
#if defined(NOHACK2) || defined(FUSED_OLD)
      pg8::EpiUp E{(pg8::bf16_t*)(ws + WS_G), (float*)(ws + WS_EDGE), (const float*)(ws + WS_ROWSS), args.in[I_FCW], args.in[I_FCB], (LAS float*)(ldsl + LDS_AUX)};
      pg8::gemm_phase<pg8::EpiUp, pg8::StaticOrder, true, true>(ldsl, g, S, E); }
#else
      pg8::EpiUp2 E{(pg8::bf16_t*)(ws + WS_G), (float*)(ws + WS_EDGE), (const float*)(ws + WS_ROWSS), args.in[I_FCW], args.in[I_FCB], (LAS float*)(ldsl + LDS_AUX)};
      pg8::gemm_phase<pg8::EpiUp2, pg8::StaticOrder, true, true>(ldsl, g, S, E); }
#endif
    GSYNC();
#if !defined(FIXUP_LOCAL) && !defined(DBG_NOHALO)
    ffn_fixup(args);
    GSYNC();
#elif !defined(DBG_NOHALO)
    { pg8::StaticOrder S; S.init(T, 1024, G, bx); pg8::Unit uu; int last = -1; const int tidf = opaque_tid();
      for (int i = 0; S.next(i, uu); ++i) { if (uu.pm != last) ffn_fixup_tile(args, uu.pm, tidf); last = uu.pm; }
      __threadfence(); __syncthreads(); }
#endif
#endif
    { pg8::Gemm g{(const pg8::bf16_t*)(ws + FFN_A), (const pg8::bf16_t*)(ws + WS_WDOWN), T, 1024, DFF, FFN_LDA}; pg8::StaticOrder S; S.init(T, 1024, G, bx);
      pg8::EpiDown E{args.out, (float*)(ws + WS_ROWSS2), (pg8::bf16_t*)(ws + WS_H1B)};
      pg8::gemm_phase<pg8::EpiDown, pg8::StaticOrder, true, true>(ldsl, g, S, E); }
#ifdef PROBE_DUMMY
    { pg8::Gemm g{(const pg8::bf16_t*)(ws + FFN_A), (const pg8::bf16_t*)(ws + WS_WDOWN), T, 1024, DFF, FFN_LDA}; pg8::StaticOrder S; S.init(T, 1024, G, bx);
      pg8::EpiDown E{(float*)(ws + 6 * MiB), (float*)(ws + WS_DC), (pg8::bf16_t*)(ws + WS_MQ)};
      pg8::gemm_phase<pg8::EpiDown, pg8::StaticOrder, true, true>(ldsl, g, S, E); }
#endif
    GSYNC();
#ifdef REP_SYNC
    for (int rep_ = 0; rep_ < REP_SYNC; ++rep_) GSYNC();
#endif
#ifdef PROBE_DUMMY
    final_norm(args, (float*)(ws + WS_MQR));
#endif
    final_norm(args, args.out);
}

extern "C" void kernel_launch(void* const* d_in, const int* in_sizes, int n_in, void* d_out, int out_size, void* d_ws, size_t ws_size, hipStream_t stream) {
    static int grid = 0;
    if (grid == 0) {
        if (n_in != 16 || in_sizes[0] != T * DM || out_size != T * DM || ws_size < WS_END) { fprintf(stderr, "kernel_launch: unexpected shapes (n_in %d, in0 %d, out %d, ws %zu); nothing launched\n", n_in, n_in > 0 ? in_sizes[0] : -1, out_size, ws_size); grid = -1; return; }
        int dev = 0, cus = 0, per_cu = 0;
        if (hipGetDevice(&dev) != hipSuccess || hipDeviceGetAttribute(&cus, hipDeviceAttributeMultiprocessorCount, dev) != hipSuccess) { grid = -1; return; }
        if (hipFuncSetAttribute((const void*)hymba_fwd, hipFuncAttributeMaxDynamicSharedMemorySize, LDS_BYTES) != hipSuccess) { fprintf(stderr, "kernel_launch: hipFuncSetAttribute failed\n"); grid = -1; return; }
        if (hipOccupancyMaxActiveBlocksPerMultiprocessor(&per_cu, (const void*)hymba_fwd, NTHREADS, LDS_BYTES) != hipSuccess || per_cu < 1) { fprintf(stderr, "kernel_launch: occupancy query says %d\n", per_cu); per_cu = 1; }
        (void)hipGetLastError();
        grid = cus * 1;
    }
    if (grid < 0) return;
    if (hipMemsetAsync((char*)d_ws + WS_BAR, 0, XCD_BAR_WORDS * 4, stream) != hipSuccess) { fprintf(stderr, "kernel_launch: memset failed\n"); return; }
    Args a{};
    for (int i = 0; i < 16; ++i) a.in[i] = (const float*)d_in[i];
    a.out = (float*)d_out; a.ws = (unsigned char*)d_ws;
    void* kargs[] = {&a};
    const hipError_t e = hipLaunchCooperativeKernel((const void*)hymba_fwd, dim3(grid), dim3(NTHREADS), kargs, LDS_BYTES, stream);
    if (e != hipSuccess) fprintf(stderr, "kernel_launch: cooperative launch failed: %s (grid %d)\n", hipGetErrorString(e), grid);
}
```
